# Optimizing an MI355X kernel written in HIP

```python
import math
import jax, jax.numpy as jnp
from jax import lax
import numpy as np

D_MODEL = 1024
BATCH = 4
SEQ = 8192
DEPTH = 2

CHUNK = 64
HEAD_DIM = 64
ROPE_THETA = 10000.0
EPS = 1e-6
NEG_INF = -1e30
A_Q_HEADS = 8
A_KV_HEADS = 2
A_WINDOW = 128
A_WIN_CHUNKS = A_WINDOW // CHUNK
B_HEADS = 8
B_PREV_CHUNKS = 8
B_MAX_REL = 128
C_HEADS = 8
C_V_DIM = 2 * HEAD_DIM
Q_BLOCK = 128

A_Q = A_Q_HEADS * HEAD_DIM
A_KV = A_KV_HEADS * HEAD_DIM
A_W = A_Q
B_W = B_HEADS * HEAD_DIM
EVEN_IN = A_Q + 2 * A_KV + A_W + 4 * B_W
EVEN_MIX = A_W + B_W
C_QK = C_HEADS * 2 * HEAD_DIM
C_W = C_HEADS * C_V_DIM
ODD_IN = 2 * C_QK + 2 * C_W
N_EVEN = (DEPTH + 1) // 2
N_ODD = DEPTH // 2
EVEN_SIZES = (A_Q, A_KV, A_KV, A_W, B_W, B_W, B_W, B_W)

kernel_name = "chunk_causal_hybrid_swa_relbias_diffattn"


def rms_norm(x, g):
    xf = x.astype(jnp.float32)
    y = xf * lax.rsqrt(jnp.mean(xf * xf, axis=-1, keepdims=True) + EPS)
    return (y * g.astype(jnp.float32)).astype(x.dtype)


def rope_tables(seq):
    inv = 1.0 / (ROPE_THETA ** (jnp.arange(0, HEAD_DIM, 2, dtype=jnp.float32) / HEAD_DIM))
    ang = jnp.arange(seq, dtype=jnp.float32)[:, None] * inv[None, :]
    return jnp.cos(ang), jnp.sin(ang)


def apply_rope(x, cos, sin):
    x1, x2 = jnp.split(x.astype(jnp.float32), 2, axis=-1)
    c = cos[None, :, None, :]
    s = sin[None, :, None, :]
    return jnp.concatenate([x1 * c - x2 * s, x2 * c + x1 * s], axis=-1).astype(x.dtype)


def to_chunks(t):
    b, s = t.shape[0], t.shape[1]
    return t.reshape(b, s // CHUNK, CHUNK, *t.shape[2:])


def chunk_band(t, n_prev):
    nc = t.shape[1]
    tp = jnp.pad(t, ((0, 0), (n_prev, 0), (0, 0), (0, 0), (0, 0)))
    band = jnp.stack([tp[:, j:j + nc] for j in range(n_prev + 1)], axis=2)
    return band.reshape(t.shape[0], nc, (n_prev + 1) * CHUNK, *t.shape[3:])


def band_valid(nc, n_prev):
    c = jnp.arange(nc)[:, None]
    j = jnp.arange(n_prev + 1)[None, :]
    return jnp.repeat((c - n_prev + j) >= 0, CHUNK, axis=1)


def sliding_window_sink_attention(q, k, v, sinks):
    b, s = q.shape[0], q.shape[1]
    nc = s // CHUNK
    g = A_Q_HEADS // A_KV_HEADS
    qc = to_chunks(q).reshape(b, nc, CHUNK, A_KV_HEADS, g, HEAD_DIM)
    kb = chunk_band(to_chunks(k), A_WIN_CHUNKS)
    vb = chunk_band(to_chunks(v), A_WIN_CHUNKS)
    scores = jnp.einsum('bcqhgd,bclhd->bchgql', qc, kb).astype(jnp.float32) / math.sqrt(HEAD_DIM)
    valid = band_valid(nc, A_WIN_CHUNKS)[None, :, None, None, None, :]
    scores = jnp.where(valid, scores, NEG_INF)
    sink = sinks.astype(jnp.float32).reshape(A_KV_HEADS, g)[None, None, :, :, None, None]
    sink = jnp.broadcast_to(sink, scores.shape[:-1] + (1,))
    probs = jax.nn.softmax(jnp.concatenate([scores, sink], axis=-1), axis=-1)[..., :-1]
    out = jnp.einsum('bchgql,bclhd->bcqhgd', probs.astype(v.dtype), vb)
    return out.reshape(b, s, A_Q_HEADS * HEAD_DIM)


def chunked_relbias_attention(q, k, v, rel_table):
    b, s = q.shape[0], q.shape[1]
    nc = s // CHUNK
    band_len = (B_PREV_CHUNKS + 1) * CHUNK
    qc = to_chunks(q)
    kb = chunk_band(to_chunks(k), B_PREV_CHUNKS)
    vb = chunk_band(to_chunks(v), B_PREV_CHUNKS)
    scores = jnp.einsum('bcqhd,bclhd->bhcql', qc, kb).astype(jnp.float32) / math.sqrt(HEAD_DIM)
    qpos = B_PREV_CHUNKS * CHUNK + jnp.arange(CHUNK)
    kpos = jnp.arange(band_len)
    rel = jnp.clip(qpos[:, None] - kpos[None, :], -B_MAX_REL, B_MAX_REL) + B_MAX_REL
    bias = rel_table.astype(jnp.float32)[:, rel]
    scores = scores + bias[None, :, None, :, :]
    valid = band_valid(nc, B_PREV_CHUNKS)[None, None, :, None, :]
    probs = jax.nn.softmax(jnp.where(valid, scores, NEG_INF), axis=-1)
    out = jnp.einsum('bhcql,bclhd->bcqhd', probs.astype(v.dtype), vb)
    return out.reshape(b, s, B_HEADS * HEAD_DIM)


def differential_attention(q1, q2, k1, k2, v, lam):
    b, s = q1.shape[0], q1.shape[1]
    nb = s // Q_BLOCK
    scale = 1.0 / math.sqrt(HEAD_DIM)
    kchunk = jnp.arange(s) // CHUNK

    def block(i):
        start = i * Q_BLOCK
        qb1 = lax.dynamic_slice_in_dim(q1, start, Q_BLOCK, axis=1)
        qb2 = lax.dynamic_slice_in_dim(q2, start, Q_BLOCK, axis=1)
        qchunk = (start + jnp.arange(Q_BLOCK)) // CHUNK
        mask = (kchunk[None, :] <= qchunk[:, None])[None, None]
        s1 = jnp.einsum('bqhd,bkhd->bhqk', qb1, k1).astype(jnp.float32) * scale
        s2 = jnp.einsum('bqhd,bkhd->bhqk', qb2, k2).astype(jnp.float32) * scale
        p1 = jax.nn.softmax(jnp.where(mask, s1, NEG_INF), axis=-1)
        p2 = jax.nn.softmax(jnp.where(mask, s2, NEG_INF), axis=-1)
        a = p1 - lam * p2
        return jnp.einsum('bhqk,bkhd->bqhd', a.astype(v.dtype), v)

    out = lax.map(block, jnp.arange(nb))
    return jnp.transpose(out, (1, 0, 2, 3, 4)).reshape(b, s, C_HEADS, C_V_DIM)


def even_layer(x, norm_g, w_in, w_out, a_qn, a_kn, a_sinks, b_qn, b_kn, b_rel, cos, sin):
    b, s, _ = x.shape
    h = rms_norm(x, norm_g)
    proj = h @ w_in
    cuts = [int(c) for c in np.cumsum(EVEN_SIZES)[:-1]]
    aq, ak, av, ag, bq, bk, bv, bg = jnp.split(proj, cuts, axis=-1)
    aq = apply_rope(rms_norm(aq.reshape(b, s, A_Q_HEADS, HEAD_DIM), a_qn), cos, sin)
    ak = apply_rope(rms_norm(ak.reshape(b, s, A_KV_HEADS, HEAD_DIM), a_kn), cos, sin)
    av = av.reshape(b, s, A_KV_HEADS, HEAD_DIM)
    ya = sliding_window_sink_attention(aq, ak, av, a_sinks) * jax.nn.silu(ag)
    bq = rms_norm(bq.reshape(b, s, B_HEADS, HEAD_DIM), b_qn)
    bk = rms_norm(bk.reshape(b, s, B_HEADS, HEAD_DIM), b_kn)
    bv = bv.reshape(b, s, B_HEADS, HEAD_DIM)
    yb = chunked_relbias_attention(bq, bk, bv, b_rel) * jax.nn.silu(bg)
    y = jnp.concatenate([ya, yb], axis=-1) @ w_out
    return x + y


def odd_layer(x, norm_g, w_in, w_out, qn, kn, lq1, lk1, lq2, lk2, subln_g, cos, sin, lambda_init):
    b, s, _ = x.shape
    h = rms_norm(x, norm_g)
    proj = h @ w_in
    q, k, v, gate = jnp.split(proj, [C_QK, 2 * C_QK, 2 * C_QK + C_W], axis=-1)
    q = rms_norm(q.reshape(b, s, C_HEADS, 2, HEAD_DIM), qn)
    k = rms_norm(k.reshape(b, s, C_HEADS, 2, HEAD_DIM), kn)
    q1 = apply_rope(q[:, :, :, 0], cos, sin)
    q2 = apply_rope(q[:, :, :, 1], cos, sin)
    k1 = apply_rope(k[:, :, :, 0], cos, sin)
    k2 = apply_rope(k[:, :, :, 1], cos, sin)
    v = v.reshape(b, s, C_HEADS, C_V_DIM)
    lam = (jnp.exp(jnp.sum(lq1.astype(jnp.float32) * lk1.astype(jnp.float32)))
           - jnp.exp(jnp.sum(lq2.astype(jnp.float32) * lk2.astype(jnp.float32)))
           + lambda_init)
    o = differential_attention(q1, q2, k1, k2, v, lam)
    o = rms_norm(o, subln_g) * (1.0 - lambda_init)
    y = (o.reshape(b, s, C_W) * jax.nn.silu(gate)) @ w_out
    return x + y


def setup_inputs(seed: int = 0) -> dict:
    key = jax.random.key(seed)
    ks = jax.random.split(key, 24)
    f32 = jnp.float32

    def gain(k, shape):
        return jnp.ones(shape, f32) + 0.02 * jax.random.normal(k, shape, f32)

    return {
        "x": jax.random.normal(ks[0], (BATCH, SEQ, D_MODEL), f32),
        "ev_norm": gain(ks[1], (N_EVEN, D_MODEL)),
        "ev_w_in": jax.random.normal(ks[2], (N_EVEN, D_MODEL, EVEN_IN), f32) * D_MODEL ** -0.5,
        "ev_w_out": jax.random.normal(ks[3], (N_EVEN, EVEN_MIX, D_MODEL), f32) * EVEN_MIX ** -0.5,
        "ev_a_q_norm": gain(ks[4], (N_EVEN, HEAD_DIM)),
        "ev_a_k_norm": gain(ks[5], (N_EVEN, HEAD_DIM)),
        "ev_a_sinks": jax.random.normal(ks[6], (N_EVEN, A_Q_HEADS), f32),
        "ev_b_q_norm": gain(ks[7], (N_EVEN, HEAD_DIM)),
        "ev_b_k_norm": gain(ks[8], (N_EVEN, HEAD_DIM)),
        "ev_b_rel_bias": 0.5 * jax.random.normal(ks[9], (N_EVEN, B_HEADS, 2 * B_MAX_REL + 1), f32),
        "od_norm": gain(ks[10], (N_ODD, D_MODEL)),
        "od_w_in": jax.random.normal(ks[11], (N_ODD, D_MODEL, ODD_IN), f32) * D_MODEL ** -0.5,
        "od_w_out": jax.random.normal(ks[12], (N_ODD, C_W, D_MODEL), f32) * C_W ** -0.5,
        "od_q_norm": gain(ks[13], (N_ODD, HEAD_DIM)),
        "od_k_norm": gain(ks[14], (N_ODD, HEAD_DIM)),
        "od_lambda_q1": 0.1 * jax.random.normal(ks[15], (N_ODD, HEAD_DIM), f32),
        "od_lambda_k1": 0.1 * jax.random.normal(ks[16], (N_ODD, HEAD_DIM), f32),
        "od_lambda_q2": 0.1 * jax.random.normal(ks[17], (N_ODD, HEAD_DIM), f32),
        "od_lambda_k2": 0.1 * jax.random.normal(ks[18], (N_ODD, HEAD_DIM), f32),
        "od_subln": gain(ks[19], (N_ODD, C_V_DIM)),
    }


def reference(x, ev_norm, ev_w_in, ev_w_out, ev_a_q_norm, ev_a_k_norm, ev_a_sinks,
              ev_b_q_norm, ev_b_k_norm, ev_b_rel_bias, od_norm, od_w_in, od_w_out,
              od_q_norm, od_k_norm, od_lambda_q1, od_lambda_k1, od_lambda_q2,
              od_lambda_k2, od_subln):
    cos, sin = rope_tables(x.shape[1])
    for layer in range(DEPTH):
        i = layer // 2
        if layer % 2 == 0:
            x = even_layer(x, ev_norm[i], ev_w_in[i], ev_w_out[i], ev_a_q_norm[i],
                           ev_a_k_norm[i], ev_a_sinks[i], ev_b_q_norm[i], ev_b_k_norm[i],
                           ev_b_rel_bias[i], cos, sin)
        else:
            lambda_init = 0.8 - 0.6 * math.exp(-0.3 * layer)
            x = odd_layer(x, od_norm[i], od_w_in[i], od_w_out[i], od_q_norm[i], od_k_norm[i],
                          od_lambda_q1[i], od_lambda_k1[i], od_lambda_q2[i], od_lambda_k2[i],
                          od_subln[i], cos, sin, lambda_init)
    return x
```

```cpp
#include <hip/hip_runtime.h>
#include <hip/hip_cooperative_groups.h>
#include <cstdio>
#include <cstdint>
namespace cg = cooperative_groups;

#ifndef MK_N_LAUNCHES
#define MK_N_LAUNCHES 7
#endif

#define LAS __attribute__((address_space(3)))
typedef unsigned short bf16_t;
typedef short bf16x8 __attribute__((ext_vector_type(8)));
typedef short s16x4 __attribute__((ext_vector_type(4)));
typedef float f32x4 __attribute__((ext_vector_type(4)));
typedef float f32x16 __attribute__((ext_vector_type(16)));
typedef unsigned u32x4 __attribute__((ext_vector_type(4)));
typedef unsigned u32x2 __attribute__((ext_vector_type(2)));

constexpr int BATCH = 4, SEQ = 8192, DM = 1024, M_ROWS = BATCH * SEQ;
constexpr int N0 = 3328, N1 = 4096;
constexpr float EPS = 1e-6f;
constexpr float LOG2E = 1.4426950408889634f;
constexpr float C2 = 0.125f * LOG2E;
constexpr float LAMBDA_INIT = 0.35550906759096927f;
constexpr int C_AQ = 0, C_AK = 512, C_AV = 640, C_AG = 768, C_BQ = 1280, C_BK = 1792, C_BV = 2304, C_BG = 2816;
constexpr int C_CQ = 0, C_CK = 1024, C_CV = 2048, C_CG = 3072;

constexpr size_t MiB = 1u << 20;
constexpr size_t WS_W0T = 1 * MiB;
constexpr size_t WS_WO0T = 8 * MiB;
constexpr size_t WS_W1T = 10 * MiB;
constexpr size_t WS_WO1T = 18 * MiB;
constexpr size_t WS_ROPE = 20 * MiB;
constexpr size_t WS_SS = 22 * MiB;
constexpr size_t WS_XN = 32 * MiB;
constexpr size_t WS_MIX = 96 * MiB;
constexpr size_t WS_PROJ = 160 * MiB;
constexpr size_t WS_END = 416 * MiB;

namespace pg8 {
constexpr int BM = 256, BK = 64, HALF = 128, HTB = HALF * BK * 2, STAGE_BYTES = 8 * HTB, NXCD = 8, WGM = 8;
__host__ __device__ __forceinline__ int lds_byte(int r, int c) { const int st = (r >> 4) * 2 + (c >> 5), rr = r & 15, cc = c & 31, ob = rr * 64 + cc * 2; return st * 1024 + (ob ^ (((ob >> 9) & 1) << 5)); }
__host__ __device__ __forceinline__ void stage_rc(int b, int& R, int& C) { const int st = b / 1024, sb = b % 1024, swz = sb ^ (((sb >> 9) & 1) << 5); R = (st >> 1) * 16 + swz / 64; C = (st & 1) * 32 + (swz % 64) / 2; }
__host__ __device__ __forceinline__ int perm32(int rho) { const int n = rho >> 4, i = rho & 15; return 8 * (i >> 2) + 4 * n + (i & 3); }

struct Unit { int pm, pn; };
struct Gemm { const bf16_t* A; const bf16_t* Bt; int M, N, K; };

struct StaticOrder {
    int nM, nN, nwg, G, c;
    __host__ __device__ void init(int M, int N, int G_, int c_) { nM = M / BM; nN = N / BM; nwg = nM * nN; G = G_; c = c_; }
    __host__ __device__ bool next(int i, Unit& u) const {
        const long L = (long)i * G + c; if (L >= nwg) return false;
        int wgid = (int)L; { const int q = nwg / NXCD, r = nwg % NXCD, xcd = wgid % NXCD, off = wgid / NXCD; wgid = (xcd < r ? xcd * (q + 1) : r * (q + 1) + (xcd - r) * q) + off; }
        const int nig = WGM * nN, gid = wgid / nig, fm = gid * WGM, gsz = (nM - fm) < WGM ? (nM - fm) : WGM;
        u.pm = fm + ((wgid % nig) % gsz); u.pn = (wgid % nig) / gsz; return true;
    }
    __device__ __forceinline__ void a_ready(const Unit&) const {}
    __device__ __forceinline__ void done(const Unit&) const {}
};

__device__ __forceinline__ unsigned cvt_pk_bf16(float lo, float hi) { unsigned r; asm volatile("v_cvt_pk_bf16_f32 %0, %1, %2" : "=v"(r) : "v"(lo), "v"(hi)); return r; }

struct EpiProj {
    static constexpr bool PERM = true, AFTER_DRAIN = false;
    bf16_t* O; int ldc; int layer;
    const float* g_q; const float* g_k; const float* g_q2; const float* g_k2;
    const float* rope;
    const float* ss;
    __device__ __forceinline__ void operator()(const f32x4 (&acc)[2][2][4][2], const Unit& u, int wr, int wc, int fr, int fq) const {
        const int gh = 4 * u.pn + wc;
        const float* gp = nullptr; bool rope_on = false, silu_on = false; float sc = 1.f;
        if (layer == 0) {
            if (gh < 8) { gp = g_q; rope_on = true; sc = C2; } else if (gh < 10) { gp = g_k; rope_on = true; } else if (gh < 12) {} else if (gh < 20) { silu_on = true; }
            else if (gh < 28) { gp = g_q2; sc = C2; } else if (gh < 36) { gp = g_k2; } else if (gh < 44) {} else { silu_on = true; }
        } else {
            if (gh < 16) { gp = g_q; rope_on = true; sc = C2; } else if (gh < 32) { gp = g_k; rope_on = true; } else if (gh < 48) {} else { silu_on = true; }
        }
        f32x4 gv[2][2];
#pragma unroll
        for (int bj = 0; bj < 2; ++bj)
#pragma unroll
            for (int n = 0; n < 2; ++n) gv[bj][n] = gp ? *(const f32x4*)(gp + 32 * bj + 8 * fq + 4 * n) : (f32x4){1.f, 1.f, 1.f, 1.f};
        const int colo = u.pn * BM + 64 * wc + 8 * fq;
#pragma unroll
        for (int ai = 0; ai < 2; ++ai)
#pragma unroll
            for (int m = 0; m < 4; ++m) {
                const int row = u.pm * BM + ai * HALF + wr * 64 + m * 16 + fr;
                f32x4 v[2][2];
#pragma unroll
                for (int bj = 0; bj < 2; ++bj)
#pragma unroll
                    for (int n = 0; n < 2; ++n) v[bj][n] = acc[ai][bj][m][n];
                if (ss) {
                    const f32x4 p4 = *(const f32x4*)(ss + (size_t)row * 16 + 4 * fq);
                    float s = (p4[0] + p4[1]) + (p4[2] + p4[3]); s += __shfl_xor(s, 16); s += __shfl_xor(s, 32);
                    const float rstd = 1.0f / sqrtf(s * (1.0f / 1024.0f) + EPS);
#pragma unroll
                    for (int bj = 0; bj < 2; ++bj)
#pragma unroll
                        for (int n = 0; n < 2; ++n) v[bj][n] = v[bj][n] * rstd;
                }
                if (gp) {
                    float q = 0.f;
#pragma unroll
                    for (int bj = 0; bj < 2; ++bj)
#pragma unroll
                        for (int n = 0; n < 2; ++n) { const f32x4 x = v[bj][n]; q += (x[0] * x[0] + x[1] * x[1]) + (x[2] * x[2] + x[3] * x[3]); }
                    q += __shfl_xor(q, 16); q += __shfl_xor(q, 32);
                    const float rn = 1.0f / sqrtf(q * (1.0f / 64.0f) + EPS);
#pragma unroll
                    for (int bj = 0; bj < 2; ++bj)
#pragma unroll
                        for (int n = 0; n < 2; ++n) v[bj][n] = v[bj][n] * rn * gv[bj][n];
                }
                if (rope_on) {
                    const int pos = row & (SEQ - 1);
#pragma unroll
                    for (int n = 0; n < 2; ++n) {
                        const f32x4 c = *(const f32x4*)(rope + (size_t)pos * 32 + 8 * fq + 4 * n);
                        const f32x4 s = *(const f32x4*)(rope + (size_t)SEQ * 32 + (size_t)pos * 32 + 8 * fq + 4 * n);
                        const f32x4 x1 = v[0][n], x2 = v[1][n];
                        v[0][n] = x1 * c - x2 * s; v[1][n] = x2 * c + x1 * s;
                    }
                }
#pragma unroll
                for (int bj = 0; bj < 2; ++bj) {
                    f32x4 a = v[bj][0] * sc, b = v[bj][1] * sc;
                    if (silu_on) {
#pragma unroll
                        for (int j = 0; j < 4; ++j) { a[j] = a[j] / (1.0f + __expf(-a[j])); b[j] = b[j] / (1.0f + __expf(-b[j])); }
                    }
                    u32x4 w; w.x = cvt_pk_bf16(a[0], a[1]); w.y = cvt_pk_bf16(a[2], a[3]); w.z = cvt_pk_bf16(b[0], b[1]); w.w = cvt_pk_bf16(b[2], b[3]);
                    *(u32x4*)(O + (size_t)row * ldc + colo + 32 * bj) = w;
                }
            }
    }
};
struct EpiRes {
    static constexpr bool PERM = true, AFTER_DRAIN = false;
    const float* base; float* out; bf16_t* xb; float* ss;
    __device__ __forceinline__ void operator()(const f32x4 (&acc)[2][2][4][2], const Unit& u, int wr, int wc, int fr, int fq) const {
#pragma unroll
        for (int ai = 0; ai < 2; ++ai)
#pragma unroll
            for (int m = 0; m < 4; ++m) {
                const int row = u.pm * BM + ai * HALF + wr * 64 + m * 16 + fr;
                float q = 0.f;
#pragma unroll
                for (int bj = 0; bj < 2; ++bj) {
                    const size_t off = (size_t)row * DM + u.pn * BM + bj * HALF + wc * 32 + 8 * fq;
                    const f32x4 b0 = *(const f32x4*)(base + off), b1 = *(const f32x4*)(base + off + 4);
                    const f32x4 a = acc[ai][bj][m][0] + b0, b = acc[ai][bj][m][1] + b1;
                    *(f32x4*)(out + off) = a; *(f32x4*)(out + off + 4) = b;
                    q += (a[0] * a[0] + a[1] * a[1]) + (a[2] * a[2] + a[3] * a[3]) + (b[0] * b[0] + b[1] * b[1]) + (b[2] * b[2] + b[3] * b[3]);
                    if (xb) { u32x4 w; w.x = cvt_pk_bf16(a[0], a[1]); w.y = cvt_pk_bf16(a[2], a[3]); w.z = cvt_pk_bf16(b[0], b[1]); w.w = cvt_pk_bf16(b[2], b[3]); *(u32x4*)(xb + off) = w; }
                }
                if (ss) { q += __shfl_xor(q, 16); q += __shfl_xor(q, 32); if (fq == 0) ss[(size_t)row * 16 + u.pn * 4 + wc] = q; }
            }
    }
};

template <class Epi, class Sched, bool ALIGN_EPI = false, bool SP2 = false>
__device__ __forceinline__ void gemm_phase(LAS unsigned char* lds, const Gemm g, const Sched& S, const Epi& E) {
    const int tid = threadIdx.x, wid = __builtin_amdgcn_readfirstlane(tid >> 6), lane = tid & 63, wr = wid >> 2, wc = wid & 3, fr = lane & 15, fq = lane >> 4;
    const int K = g.K, nt = K / BK;
    unsigned voffA[2], voffB[2];
#pragma unroll
    for (int i = 0; i < 2; ++i) { int R, C; stage_rc(tid * 16 + i * 8192, R, C); const int Rb = Epi::PERM ? ((R & ~31) + perm32(R & 31)) : R;
        voffA[i] = (unsigned)(R * K + C) * 2u; voffB[i] = (unsigned)(Rb * K + C) * 2u; }
    const size_t kstep = (size_t)(BK * 2);
    const size_t hstep = (size_t)HALF * K * 2;
    const size_t tstep = 2 * hstep;
    const unsigned ldsw = (unsigned)wid * 1024u;
    const int aoff = lds_byte(wr * 64 + fr, fq * 8), boff = lds_byte(wc * 32 + fr, fq * 8);
#define PG8_SA(b, h) (((b) * 2 + (h)) * HTB)
#define PG8_SB(b, h) ((4 + (b) * 2 + (h)) * HTB)
#define PG8_STAGE(bufoff, gbase, voff) do { _Pragma("unroll") for (int _i = 0; _i < 2; ++_i) \
        __builtin_amdgcn_global_load_lds((const unsigned*)((const char*)(gbase) + (voff)[_i]), (LAS unsigned*)(lds + (bufoff) + ldsw + _i * 8192), 16, 0, 0); } while (0)
#define PG8_LDA(dst, b, h) do { _Pragma("unroll") for (int m = 0; m < 4; ++m) _Pragma("unroll") for (int k = 0; k < 2; ++k) dst[m][k] = *(const LAS bf16x8*)(lds + PG8_SA(b, h) + aoff + m * 2048 + k * 1024); } while (0)
#define PG8_LDB(dst, b, h) do { _Pragma("unroll") for (int n = 0; n < 2; ++n) _Pragma("unroll") for (int k = 0; k < 2; ++k) dst[n][k] = *(const LAS bf16x8*)(lds + PG8_SB(b, h) + boff + n * 2048 + k * 1024); } while (0)
#define PG8_MMA(ai, bj, At, Bt) do { __builtin_amdgcn_s_setprio(1); _Pragma("unroll") for (int m = 0; m < 4; ++m) _Pragma("unroll") for (int n = 0; n < 2; ++n) _Pragma("unroll") for (int k = 0; k < 2; ++k) \
        acc[ai][bj][m][n] = __builtin_amdgcn_mfma_f32_16x16x32_bf16(Bt[n][k], At[m][k], acc[ai][bj][m][n], 0, 0, 0); __builtin_amdgcn_s_setprio(0); } while (0)
#define PG8_WAIT_V(n) asm volatile("s_waitcnt vmcnt(" #n ")" ::: "memory")
#define PG8_WAIT_L(n) asm volatile("s_waitcnt lgkmcnt(" #n ")" ::: "memory")
#define PG8_BAR __builtin_amdgcn_s_barrier()
#define PG8_SCHED __builtin_amdgcn_sched_barrier(0)
    Unit cur, nxt; int ui = 0;
    if (!S.next(0, cur)) return;
    f32x4 acc[2][2][4][2];
#pragma unroll
    for (int a = 0; a < 2; ++a)
#pragma unroll
        for (int b = 0; b < 2; ++b)
#pragma unroll
            for (int m = 0; m < 4; ++m)
#pragma unroll
                for (int n = 0; n < 2; ++n) acc[a][b][m][n] = (f32x4){0.f, 0.f, 0.f, 0.f};
    bf16x8 At[4][2], B0[2][2], B1[2][2];
    const char* cA = (const char*)g.A + (size_t)cur.pm * tstep; const char* cB = (const char*)g.Bt + (size_t)cur.pn * tstep;
    S.a_ready(cur);
    if constexpr (SP2) {
        PG8_STAGE(PG8_SB(0, 0), cB, voffB); PG8_STAGE(PG8_SB(0, 1), cB + hstep, voffB); PG8_STAGE(PG8_SA(0, 0), cA, voffA); PG8_STAGE(PG8_SA(0, 1), cA + hstep, voffA);
        if (wr == 1) PG8_BAR;
        PG8_WAIT_V(2); PG8_BAR;
        PG8_STAGE(PG8_SB(1, 0), cB + kstep, voffB); PG8_STAGE(PG8_SA(1, 0), cA + kstep, voffA); PG8_STAGE(PG8_SB(1, 1), cB + hstep + kstep, voffB);
        PG8_WAIT_V(6); PG8_BAR;
    } else {
        PG8_STAGE(PG8_SB(0, 0), cB, voffB); PG8_STAGE(PG8_SA(0, 0), cA, voffA); PG8_STAGE(PG8_SB(0, 1), cB + hstep, voffB); PG8_STAGE(PG8_SA(0, 1), cA + hstep, voffA);
        if (wr == 1) PG8_BAR;
        PG8_WAIT_V(4); PG8_BAR;
        PG8_STAGE(PG8_SB(1, 0), cB + kstep, voffB); PG8_STAGE(PG8_SA(1, 0), cA + kstep, voffA); PG8_STAGE(PG8_SB(1, 1), cB + hstep + kstep, voffB);
        PG8_WAIT_V(6); PG8_BAR;
    }
    for (;;) {
        const bool has_next = S.next(ui + 1, nxt);
        const char* nA = has_next ? (const char*)g.A + (size_t)nxt.pm * tstep : cA; const char* nB = has_next ? (const char*)g.Bt + (size_t)nxt.pn * tstep : cB;
        for (int t = 0; t < nt; t += 2) {
            const bool last = (t == nt - 2);
            const char* a1 = cA + (size_t)(t + 1) * kstep;
            const char* a2 = last ? nA : cA + (size_t)(t + 2) * kstep; const char* b2 = last ? nB : cB + (size_t)(t + 2) * kstep;
            const char* a3 = a2 + kstep; const char* b3 = b2 + kstep;
            if (last && has_next) S.a_ready(nxt);
            if constexpr (SP2) {
            PG8_LDB(B0, 0, 0); PG8_LDB(B1, 0, 1); PG8_SCHED; PG8_LDA(At, 0, 0); PG8_STAGE(PG8_SA(1, 1), a1 + hstep, voffA);
            PG8_WAIT_V(8); PG8_WAIT_L(0); PG8_BAR; PG8_MMA(0, 0, At, B0); PG8_MMA(0, 1, At, B1); PG8_BAR; PG8_SCHED;
            PG8_LDA(At, 0, 1); PG8_STAGE(PG8_SB(0, 0), b2, voffB); PG8_STAGE(PG8_SB(0, 1), b2 + hstep, voffB); PG8_STAGE(PG8_SA(0, 0), a2, voffA);
            PG8_WAIT_V(8); PG8_WAIT_L(0); PG8_BAR; PG8_MMA(1, 0, At, B0); PG8_MMA(1, 1, At, B1); PG8_BAR; PG8_SCHED;
            PG8_LDB(B0, 1, 0); PG8_LDB(B1, 1, 1); PG8_SCHED; PG8_LDA(At, 1, 0); PG8_STAGE(PG8_SA(0, 1), a2 + hstep, voffA);
            PG8_WAIT_V(8); PG8_WAIT_L(0); PG8_BAR; PG8_MMA(0, 0, At, B0); PG8_MMA(0, 1, At, B1); PG8_BAR; PG8_SCHED;
            PG8_LDA(At, 1, 1); PG8_STAGE(PG8_SB(1, 0), b3, voffB); PG8_STAGE(PG8_SB(1, 1), b3 + hstep, voffB); PG8_STAGE(PG8_SA(1, 0), a3, voffA);
            PG8_WAIT_V(8); PG8_WAIT_L(0); PG8_BAR; PG8_MMA(1, 0, At, B0); PG8_MMA(1, 1, At, B1); PG8_BAR; PG8_SCHED;
            } else {
            PG8_LDB(B0, 0, 0); PG8_SCHED; PG8_LDA(At, 0, 0); PG8_STAGE(PG8_SA(1, 1), a1 + hstep, voffA);
            PG8_WAIT_L(8); PG8_BAR; PG8_WAIT_L(0); PG8_MMA(0, 0, At, B0); PG8_BAR; PG8_SCHED;
            PG8_LDB(B1, 0, 1); PG8_STAGE(PG8_SB(0, 0), b2, voffB);
            PG8_BAR; PG8_WAIT_L(0); PG8_MMA(0, 1, At, B1); PG8_BAR;
            PG8_LDA(At, 0, 1); PG8_STAGE(PG8_SA(0, 0), a2, voffA);
            PG8_BAR; PG8_WAIT_L(0); PG8_MMA(1, 0, At, B0); PG8_BAR; PG8_SCHED;
            PG8_STAGE(PG8_SB(0, 1), b2 + hstep, voffB);
            PG8_WAIT_V(6); PG8_BAR; PG8_MMA(1, 1, At, B1); PG8_BAR;
            PG8_LDB(B0, 1, 0); PG8_SCHED; PG8_LDA(At, 1, 0); PG8_STAGE(PG8_SA(0, 1), a2 + hstep, voffA);
            PG8_WAIT_L(8); PG8_BAR; PG8_WAIT_L(0); PG8_MMA(0, 0, At, B0); PG8_BAR; PG8_SCHED;
            PG8_LDB(B1, 1, 1); PG8_STAGE(PG8_SB(1, 0), b3, voffB);
            PG8_BAR; PG8_WAIT_L(0); PG8_MMA(0, 1, At, B1); PG8_BAR;
            PG8_LDA(At, 1, 1); PG8_STAGE(PG8_SA(1, 0), a3, voffA);
            PG8_BAR; PG8_WAIT_L(0); PG8_MMA(1, 0, At, B0); PG8_BAR; PG8_SCHED;
            PG8_STAGE(PG8_SB(1, 1), b3 + hstep, voffB);
            PG8_WAIT_V(6); PG8_BAR; PG8_MMA(1, 1, At, B1); PG8_BAR;
            }
        }
        if constexpr (ALIGN_EPI) { if (wr == 0) PG8_BAR; }
        if constexpr (!Epi::AFTER_DRAIN) { E(acc, cur, wr, wc, fr, fq); S.done(cur); }
        if (!has_next) break;
#pragma unroll
        for (int a = 0; a < 2; ++a)
#pragma unroll
            for (int b = 0; b < 2; ++b)
#pragma unroll
                for (int m = 0; m < 4; ++m)
#pragma unroll
                    for (int n = 0; n < 2; ++n) acc[a][b][m][n] = (f32x4){0.f, 0.f, 0.f, 0.f};
        cur = nxt; cA = nA; cB = nB; ++ui;
        if constexpr (ALIGN_EPI) { if (wr == 1) PG8_BAR; }
    }
    PG8_WAIT_V(0);
    if constexpr (!ALIGN_EPI) { if (wr == 0) PG8_BAR; }
    PG8_BAR;
#undef PG8_SA
#undef PG8_SB
#undef PG8_STAGE
#undef PG8_LDA
#undef PG8_LDB
#undef PG8_MMA
#undef PG8_WAIT_V
#undef PG8_WAIT_L
#undef PG8_BAR
#undef PG8_SCHED
}
}

namespace sa {
typedef LAS const char* lds_cptr;
typedef short v4i16_t __attribute__((ext_vector_type(4)));
__device__ __forceinline__ unsigned cvtpk(float lo, float hi) { unsigned r; asm("v_cvt_pk_bf16_f32 %0, %1, %2" : "=v"(r) : "v"(lo), "v"(hi)); return r; }
__device__ __forceinline__ void glds16(const void* g, unsigned lds_base) {
    unsigned sv; asm volatile("s_mov_b32 %0, m0\n\ts_mov_b32 m0, %2\n\ts_nop 0\n\tglobal_load_lds_dwordx4 %1, off\n\ts_mov_b32 m0, %0" : "=&s"(sv) : "v"(g), "s"(lds_base) : "memory"); }
__device__ __forceinline__ s16x4 vtr(lds_cptr p) { return __builtin_bit_cast(s16x4, __builtin_amdgcn_ds_read_tr16_b64_v4i16((LAS v4i16_t*)p)); }
#define SA_MFMA(a, b, c) __builtin_amdgcn_mfma_f32_32x32x16_bf16(a, b, c, 0, 0, 0)
#define SA_WAIT_BAR() asm volatile("s_waitcnt vmcnt(0) lgkmcnt(0)\n\ts_barrier" ::: "memory")
__device__ __forceinline__ float swap_sum(float v) { auto rr = __builtin_amdgcn_permlane32_swap(__float_as_uint(v), __float_as_uint(v), false, false); return __uint_as_float(rr[0]) + __uint_as_float(rr[1]); }
__device__ __forceinline__ float swap_max(float v) { auto rr = __builtin_amdgcn_permlane32_swap(__float_as_uint(v), __float_as_uint(v), false, false); return fmaxf(__uint_as_float(rr[0]), __uint_as_float(rr[1])); }
__device__ __forceinline__ float bf_lo(unsigned w) { return __uint_as_float(w << 16); }
__device__ __forceinline__ float bf_hi(unsigned w) { return __uint_as_float(w & 0xffff0000u); }

template <int NDB> struct Lay {
    static constexpr int SLOT_K = 8192, SLOT_V = NDB * 4096, SLOT = SLOT_K + SLOT_V;
    static constexpr int WSF = 2 * SLOT, TAB = WSF + 2048, STG = TAB + 1280, STG_W = 8192, END = STG + 8 * STG_W;
};

template <int NDB, int MODE>
__device__ __forceinline__ void stream(LAS char* lds, const bf16_t* Qw, int pq, const bf16_t* Kh, int pk, const bf16_t* Vh, int pv, int t_lo, int t_hi, int w_lo, int w_hi,
                                       int cw, int qi0, f32x16 (&o)[NDB], float& m, float& l) {
    typedef Lay<NDB> L;
    const int tid = threadIdx.x, lane = tid & 63, r32 = lane & 31, hi = lane >> 5; const int wid = __builtin_amdgcn_readfirstlane(tid >> 6);
    const unsigned lds0 = (unsigned)(size_t)lds;
    LAS float* wsf = (LAS float*)(lds + L::WSF) + wid * 64;
    const LAS float* tab = (const LAS float*)(lds + L::TAB);
    const bf16_t* ksrc = Kh + (size_t)lane * pk + wid * 8;
    auto issue = [&](int t, int slot) {
        glds16(ksrc + (size_t)t * 64 * pk, (unsigned)__builtin_amdgcn_readfirstlane(lds0 + slot * L::SLOT + wid * 1024));
#pragma unroll
        for (int j = 0; j < NDB / 2; ++j) { const int pc = wid + 8 * j;
            const bf16_t* vsrc = Vh + (size_t)(t * 64 + 16 * (pc & 3) + (lane >> 2)) * pv + (pc >> 2) * 32 + (lane & 3) * 8;
            glds16(vsrc, (unsigned)__builtin_amdgcn_readfirstlane(lds0 + slot * L::SLOT + L::SLOT_K + pc * 1024)); }
    };
    issue(t_lo, 0);
    bf16x8 qr[4];
#pragma unroll
    for (int d0 = 0; d0 < 4; ++d0) qr[d0] = *(const bf16x8*)(Qw + (size_t)r32 * pq + d0 * 16 + hi * 8);
#pragma unroll
    for (int d0 = 0; d0 < NDB; ++d0) o[d0] = f32x16{};
    m = -1.0e30f; l = 0.f;
    SA_WAIT_BAR();
    for (int t = t_lo; t < t_hi; ++t) {
        const int cur = (t - t_lo) & 1;
        if (t + 1 < t_hi) issue(t + 1, cur ^ 1);
        if (t >= w_lo && t <= w_hi) {
            const lds_cptr kb = (lds_cptr)lds + cur * L::SLOT + hi * 1024 + r32 * 16;
            f32x16 p0, p1;
#pragma unroll
            for (int d0 = 0; d0 < 4; ++d0) {
                const bf16x8 b0 = *(const LAS bf16x8*)(kb + d0 * 2048), b1 = *(const LAS bf16x8*)(kb + d0 * 2048 + 512);
                if (d0 == 0) { p0 = SA_MFMA(b0, qr[0], f32x16{}); p1 = SA_MFMA(b1, qr[0], f32x16{}); }
                else { p0 = SA_MFMA(b0, qr[d0], p0); p1 = SA_MFMA(b1, qr[d0], p1); }
            }
            if (MODE == 1) {
                const int dist = cw - t;
                if (dist >= 3) { const float cb = tab[256];
#pragma unroll
                    for (int r = 0; r < 16; ++r) { p0[r] += cb; p1[r] += cb; } }
                else { const int ib = dist * 64 + qi0 + r32 + 128 - 4 * hi;
#pragma unroll
                    for (int r = 0; r < 16; ++r) { const int k = (r & 3) + 8 * (r >> 2); int i0 = ib - k, i1 = ib - k - 32; i0 = i0 > 256 ? 256 : i0; i1 = i1 > 256 ? 256 : i1; p0[r] += tab[i0]; p1[r] += tab[i1]; } }
            }
            float rm = fmaxf(p0[0], p1[0]);
#pragma unroll
            for (int r = 1; r < 16; ++r) rm = fmaxf(rm, fmaxf(p0[r], p1[r]));
            rm = swap_max(rm);
            if (__any(rm > m)) {
                const float mn = fmaxf(m, rm), al = __builtin_amdgcn_exp2f(m - mn); l *= al; m = mn;
                if (hi == 0) wsf[r32] = al;
#pragma unroll
                for (int g = 0; g < 4; ++g) { const f32x4 a4 = *(const LAS f32x4*)(wsf + 8 * g + 4 * hi);
#pragma unroll
                    for (int d0 = 0; d0 < NDB; ++d0)
#pragma unroll
                        for (int j = 0; j < 4; ++j) o[d0][4 * g + j] *= a4[j]; }
            }
            float sum = 0.f;
#pragma unroll
            for (int r = 0; r < 16; ++r) { p0[r] = __builtin_amdgcn_exp2f(p0[r] - m); p1[r] = __builtin_amdgcn_exp2f(p1[r] - m); sum += p0[r] + p1[r]; }
            l += sum;
            u32x4 pw[4];
#pragma unroll
            for (int j = 0; j < 4; ++j) { pw[0][j] = cvtpk(p0[2 * j], p0[2 * j + 1]); pw[1][j] = cvtpk(p0[8 + 2 * j], p0[9 + 2 * j]); pw[2][j] = cvtpk(p1[2 * j], p1[2 * j + 1]); pw[3][j] = cvtpk(p1[8 + 2 * j], p1[9 + 2 * j]); }
            const lds_cptr vp = (lds_cptr)lds + cur * L::SLOT + L::SLOT_K + ((lane >> 4) & 1) * 32 + (lane & 3) * 8 + (4 * hi + ((lane & 15) >> 2)) * 64;
#pragma unroll
            for (int d0 = 0; d0 < NDB; ++d0) {
#pragma unroll
                for (int ks = 0; ks < 4; ++ks) {
                    const s16x4 lo = vtr(vp + d0 * 4096 + ks * 1024), hh = vtr(vp + d0 * 4096 + ks * 1024 + 512);
                    const bf16x8 vf = (bf16x8){lo[0], lo[1], lo[2], lo[3], hh[0], hh[1], hh[2], hh[3]};
                    o[d0] = SA_MFMA(__builtin_bit_cast(bf16x8, pw[ks]), vf, o[d0]);
                }
            }
        }
        SA_WAIT_BAR();
    }
}
}

constexpr int NWAVES = 8;
constexpr int LDS_BYTES = 147456;
constexpr int N_PHASES = 7;
static_assert(sa::Lay<4>::END <= pg8::STAGE_BYTES && sa::Lay<2>::END <= pg8::STAGE_BYTES, "attention LDS layout fits the stage region");

struct Args { const float* in[20]; float* out; unsigned char* ws; int ph_lo, ph_hi; };

__device__ __forceinline__ float wave_sum(float v) {
#pragma unroll
    for (int o = 1; o < 64; o <<= 1) v += __shfl_xor(v, o);
    return v;
}
__device__ __forceinline__ unsigned f2bf(float f) { unsigned u = __builtin_bit_cast(unsigned, f); return (u + 0x7fffu + ((u >> 16) & 1u)) >> 16; }
__device__ __forceinline__ unsigned pk2(float lo, float hi) { return f2bf(lo) | (f2bf(hi) << 16); }

__device__ __forceinline__ void transpose_item(const float* W, int K, int N, bf16_t* WT, bool permute, const float* gk, LAS float* scr, int item, int lane) {
    const int nblk = N / 32, kb = item / nblk, nb = item % nblk, k0 = 64 * kb, n0 = 32 * nb;
#pragma unroll 8
    for (int i = 0; i < 32; ++i) { const int kk = 2 * i + (lane >> 5); float w = W[(size_t)(k0 + kk) * N + n0 + (lane & 31)]; if (gk) w *= gk[k0 + kk]; scr[kk * 33 + (lane & 31)] = w; }
    asm volatile("s_waitcnt lgkmcnt(0)" ::: "memory");
    int prow0 = n0;
    if (permute) { const int gl = (n0 & 255) >> 5, wc = gl >> 1, bj = gl & 1; prow0 = (n0 & ~255) + (4 * bj + wc) * 32; }
    const int c = lane & 7;
#pragma unroll
    for (int j = 0; j < 4; ++j) { const int n = (lane >> 3) + 8 * j; const LAS float* s = scr + (8 * c) * 33 + n;
        u32x4 o; o.x = pk2(s[0 * 33], s[1 * 33]); o.y = pk2(s[2 * 33], s[3 * 33]); o.z = pk2(s[4 * 33], s[5 * 33]); o.w = pk2(s[6 * 33], s[7 * 33]);
        *(u32x4*)(WT + (size_t)(prow0 + n) * K + k0 + 8 * c) = o; }
    asm volatile("s_waitcnt lgkmcnt(0)" ::: "memory");
}

__global__ void __launch_bounds__(NWAVES * 64, 2) fwd_kernel(Args args) {
    extern __shared__ __attribute__((aligned(16))) unsigned char lds_raw[];
    LAS unsigned char* lds = (LAS unsigned char*)lds_raw;
    const int tid = threadIdx.x, lane = tid & 63, wid = __builtin_amdgcn_readfirstlane(tid >> 6);
    const int G = gridDim.x, bx = blockIdx.x;
    const int vcu = (G % 8 == 0) ? (bx % 8) * (G / 8) + bx / 8 : bx;
    const int r32 = lane & 31, hi = lane >> 5;
    unsigned char* ws = args.ws;
    const float* x = args.in[0];
    float* out = args.out;
    bf16_t* W0T = (bf16_t*)(ws + WS_W0T); bf16_t* WO0T = (bf16_t*)(ws + WS_WO0T); bf16_t* W1T = (bf16_t*)(ws + WS_W1T); bf16_t* WO1T = (bf16_t*)(ws + WS_WO1T);
    float* ROPE = (float*)(ws + WS_ROPE); float* SS = (float*)(ws + WS_SS);
    bf16_t* XN = (bf16_t*)(ws + WS_XN); bf16_t* MIX = (bf16_t*)(ws + WS_MIX); bf16_t* PROJ = (bf16_t*)(ws + WS_PROJ);
    const int lo = args.ph_lo, hi_ph = args.ph_hi;
#define IN(k) (lo <= (k) && (k) < hi_ph)
#define SEAM(k) do { if (IN(k) && IN((k) + 1)) { cg::this_grid().sync(); } } while (0)

    if (IN(0)) {
        LAS float* scr = (LAS float*)(lds + wid * 16384);
        const int gw = vcu * NWAVES + wid, NGW = G * NWAVES;
        constexpr int I_0 = (DM / 64) * (N0 / 32), I_O = (DM / 64) * (DM / 32), I_1 = (DM / 64) * (N1 / 32);
        constexpr int NITEMS = I_0 + I_O + I_1 + I_O;
        for (int it = gw; it < NITEMS; it += NGW) {
            int r = it;
            if (r < I_0) { transpose_item(args.in[2], DM, N0, W0T, true, nullptr, scr, r, lane); continue; } r -= I_0;
            if (r < I_O) { transpose_item(args.in[3], DM, DM, WO0T, false, nullptr, scr, r, lane); continue; } r -= I_O;
            if (r < I_1) { transpose_item(args.in[11], DM, N1, W1T, true, args.in[10], scr, r, lane); continue; } r -= I_1;
            transpose_item(args.in[12], DM, DM, WO1T, false, nullptr, scr, r, lane);
        }
        for (int e = (vcu * NWAVES * 64) + tid; e < SEQ * 32; e += G * NWAVES * 64) {
            const int pos = e >> 5, i = e & 31;
            const float inv = 1.0f / powf(10000.0f, (float)(2 * i) / 64.0f);
            const float ang = (float)pos * inv;
            ROPE[e] = cosf(ang); ROPE[SEQ * 32 + e] = sinf(ang);
        }
        const float* gn = args.in[1];
        for (int mrow = gw; mrow < M_ROWS; mrow += NGW) {
            const f32x4* xr = (const f32x4*)(x + (size_t)mrow * DM) + lane;
            f32x4 v[4]; float s = 0.f;
#pragma unroll
            for (int j = 0; j < 4; ++j) { v[j] = xr[64 * j]; s += (v[j][0] * v[j][0] + v[j][1] * v[j][1]) + (v[j][2] * v[j][2] + v[j][3] * v[j][3]); }
            const float rstd = 1.0f / sqrtf(wave_sum(s) * (1.0f / DM) + EPS);
            unsigned long long* o8 = (unsigned long long*)(XN + (size_t)mrow * DM) + lane;
#pragma unroll
            for (int j = 0; j < 4; ++j) { const f32x4 g4 = *((const f32x4*)gn + lane + 64 * j);
                o8[64 * j] = (unsigned long long)pk2(v[j][0] * rstd * g4[0], v[j][1] * rstd * g4[1]) | ((unsigned long long)pk2(v[j][2] * rstd * g4[2], v[j][3] * rstd * g4[3]) << 32); }
        }
        __syncthreads();
    }
    SEAM(0);

    if (IN(1)) {
        pg8::Gemm g{XN, W0T, M_ROWS, N0, DM}; pg8::StaticOrder S; S.init(M_ROWS, N0, G, bx);
        pg8::EpiProj E{PROJ, N0, 0, args.in[4], args.in[5], args.in[7], args.in[8], ROPE, nullptr};
        pg8::gemm_phase<pg8::EpiProj, pg8::StaticOrder, true, true>(lds, g, S, E);
    }
    SEAM(1);

    if (IN(2)) {
        typedef sa::Lay<2> L;
        LAS char* al = (LAS char*)lds;
        LAS float* wsf = (LAS float*)(al + L::WSF) + wid * 64;
        LAS float* stg = (LAS float*)(al + L::STG + wid * L::STG_W);
        for (int id = vcu; id < BATCH * 2 * 128; id += G) {
            const int c = id & 127, bk = id >> 7, b = bk >> 1, kvh = bk & 1;
            const int hq = kvh * 4 + (wid >> 1);
            const size_t qrow0 = (size_t)b * SEQ + c * 64 + (wid & 1) * 32;
            const bf16_t* Qw = PROJ + qrow0 * N0 + C_AQ + hq * 64;
            const bf16_t* Kh = PROJ + (size_t)b * SEQ * N0 + C_AK + kvh * 64;
            const bf16_t* Vh = PROJ + (size_t)b * SEQ * N0 + C_AV + kvh * 64;
            const int t_lo = c >= 2 ? c - 2 : 0;
            f32x16 o[2]; float m, l;
            sa::stream<2, 0>(al, Qw, N0, Kh, N0, Vh, N0, t_lo, c + 1, t_lo, c, 0, 0, o, m, l);
            float lt = sa::swap_sum(l);
            const float s2 = args.in[6][hq] * LOG2E, mf = fmaxf(m, s2), e1 = __builtin_amdgcn_exp2f(m - mf);
            lt = lt * e1 + __builtin_amdgcn_exp2f(s2 - mf);
            const float scl = e1 / lt;
            if (hi == 0) wsf[32 + r32] = scl;
#pragma unroll
            for (int g = 0; g < 4; ++g) { const f32x4 s4 = *(const LAS f32x4*)(wsf + 32 + 8 * g + 4 * hi);
#pragma unroll
                for (int d0 = 0; d0 < 2; ++d0)
#pragma unroll
                    for (int j = 0; j < 4; ++j) stg[(8 * g + 4 * hi + j) * 64 + d0 * 32 + r32] = o[d0][4 * g + j] * s4[j]; }
#pragma unroll
            for (int i = 0; i < 4; ++i) { const int row = i * 8 + (lane >> 3), c8 = lane & 7;
                const f32x4 a = *(const LAS f32x4*)(stg + row * 64 + c8 * 8), bb = *(const LAS f32x4*)(stg + row * 64 + c8 * 8 + 4);
                const u32x4 gt = *(const u32x4*)(PROJ + (qrow0 + row) * N0 + C_AG + hq * 64 + c8 * 8);
                u32x4 w; w.x = sa::cvtpk(a[0] * sa::bf_lo(gt.x), a[1] * sa::bf_hi(gt.x)); w.y = sa::cvtpk(a[2] * sa::bf_lo(gt.y), a[3] * sa::bf_hi(gt.y));
                w.z = sa::cvtpk(bb[0] * sa::bf_lo(gt.z), bb[1] * sa::bf_hi(gt.z)); w.w = sa::cvtpk(bb[2] * sa::bf_lo(gt.w), bb[3] * sa::bf_hi(gt.w));
                *(u32x4*)(MIX + (qrow0 + row) * DM + hq * 64 + c8 * 8) = w; }
        }
        for (int id = vcu; id < BATCH * 8 * 32; id += G) {
            const int cg4 = id & 31, bh = id >> 5, b = bh >> 3, h = bh & 7;
            const int c0 = cg4 * 4, cw = c0 + (wid >> 1);
            LAS float* tabw = (LAS float*)(al + L::TAB);
            if (tid < 257) tabw[tid] = args.in[9][h * 257 + tid] * LOG2E;
            const size_t qrow0 = (size_t)b * SEQ + cw * 64 + (wid & 1) * 32;
            const bf16_t* Qw = PROJ + qrow0 * N0 + C_BQ + h * 64;
            const bf16_t* Kh = PROJ + (size_t)b * SEQ * N0 + C_BK + h * 64;
            const bf16_t* Vh = PROJ + (size_t)b * SEQ * N0 + C_BV + h * 64;
            const int t_lo = c0 >= 8 ? c0 - 8 : 0, w_lo = cw >= 8 ? cw - 8 : 0;
            f32x16 o[2]; float m, l;
            sa::stream<2, 1>(al, Qw, N0, Kh, N0, Vh, N0, t_lo, c0 + 4, w_lo, cw, cw, (wid & 1) * 32, o, m, l);
            const float scl = 1.0f / sa::swap_sum(l);
            if (hi == 0) wsf[32 + r32] = scl;
#pragma unroll
            for (int g = 0; g < 4; ++g) { const f32x4 s4 = *(const LAS f32x4*)(wsf + 32 + 8 * g + 4 * hi);
#pragma unroll
                for (int d0 = 0; d0 < 2; ++d0)
#pragma unroll
                    for (int j = 0; j < 4; ++j) stg[(8 * g + 4 * hi + j) * 64 + d0 * 32 + r32] = o[d0][4 * g + j] * s4[j]; }
#pragma unroll
            for (int i = 0; i < 4; ++i) { const int row = i * 8 + (lane >> 3), c8 = lane & 7;
                const f32x4 a = *(const LAS f32x4*)(stg + row * 64 + c8 * 8), bb = *(const LAS f32x4*)(stg + row * 64 + c8 * 8 + 4);
                const u32x4 gt = *(const u32x4*)(PROJ + (qrow0 + row) * N0 + C_BG + h * 64 + c8 * 8);
                u32x4 w; w.x = sa::cvtpk(a[0] * sa::bf_lo(gt.x), a[1] * sa::bf_hi(gt.x)); w.y = sa::cvtpk(a[2] * sa::bf_lo(gt.y), a[3] * sa::bf_hi(gt.y));
                w.z = sa::cvtpk(bb[0] * sa::bf_lo(gt.z), bb[1] * sa::bf_hi(gt.z)); w.w = sa::cvtpk(bb[2] * sa::bf_lo(gt.w), bb[3] * sa::bf_hi(gt.w));
                *(u32x4*)(MIX + (qrow0 + row) * DM + 512 + h * 64 + c8 * 8) = w; }
        }
        asm volatile("s_waitcnt vmcnt(0) lgkmcnt(0)" ::: "memory");
        __syncthreads();
    }
    SEAM(2);

    if (IN(3)) {
        pg8::Gemm g{MIX, WO0T, M_ROWS, DM, DM}; pg8::StaticOrder S; S.init(M_ROWS, DM, G, bx);
        pg8::EpiRes E{x, out, XN, SS};
        pg8::gemm_phase<pg8::EpiRes, pg8::StaticOrder, true, true>(lds, g, S, E);
    }
    SEAM(3);

    if (IN(4)) {
        pg8::Gemm g{XN, W1T, M_ROWS, N1, DM}; pg8::StaticOrder S; S.init(M_ROWS, N1, G, bx);
        pg8::EpiProj E{PROJ, N1, 1, args.in[13], args.in[14], nullptr, nullptr, ROPE, SS};
        pg8::gemm_phase<pg8::EpiProj, pg8::StaticOrder, true, true>(lds, g, S, E);
    }
    SEAM(4);

    if (IN(5)) {
        typedef sa::Lay<4> L;
        LAS char* al = (LAS char*)lds;
        LAS float* wsf = (LAS float*)(al + L::WSF) + wid * 64;
        LAS float* stg = (LAS float*)(al + L::STG + wid * L::STG_W);
        float lam;
        { const float a = args.in[15][lane] * args.in[16][lane], bq = args.in[17][lane] * args.in[18][lane];
          lam = __expf(wave_sum(a)) - __expf(wave_sum(bq)) + LAMBDA_INIT; }
        const float* subg = args.in[19];
        for (int id = vcu; id < BATCH * 8 * 32; id += G) {
            const int i = id >> 8, v = id & 255, bh = v >> 3, s = v & 7, b = bh >> 3, h = bh & 7;
            const int qb = (i == 0) ? s : (i == 1) ? 15 - s : (i == 2) ? 16 + s : 31 - s;
            const int cw = qb * 4 + (wid >> 1);
            const size_t qrow0 = (size_t)b * SEQ + qb * 256 + wid * 32;
            const bf16_t* Vh = PROJ + (size_t)b * SEQ * N1 + C_CV + h * 128;
            unsigned o2p[4][8];
            f32x16 o[4]; float m, l;
            {
                const int vh = 2 * h + 1;
                sa::stream<4, 0>(al, PROJ + qrow0 * N1 + C_CQ + vh * 64, N1, PROJ + (size_t)b * SEQ * N1 + C_CK + vh * 64, N1, Vh, N1, 0, qb * 4 + 4, 0, cw, 0, 0, o, m, l);
                const float scl = 1.0f / sa::swap_sum(l);
                if (hi == 0) wsf[32 + r32] = scl;
#pragma unroll
                for (int g = 0; g < 4; ++g) { const f32x4 s4 = *(const LAS f32x4*)(wsf + 32 + 8 * g + 4 * hi);
#pragma unroll
                    for (int d0 = 0; d0 < 4; ++d0) { o2p[d0][2 * g] = sa::cvtpk(o[d0][4 * g] * s4[0], o[d0][4 * g + 1] * s4[1]); o2p[d0][2 * g + 1] = sa::cvtpk(o[d0][4 * g + 2] * s4[2], o[d0][4 * g + 3] * s4[3]); } }
            }
            {
                const int vh = 2 * h;
                sa::stream<4, 0>(al, PROJ + qrow0 * N1 + C_CQ + vh * 64, N1, PROJ + (size_t)b * SEQ * N1 + C_CK + vh * 64, N1, Vh, N1, 0, qb * 4 + 4, 0, cw, 0, 0, o, m, l);
            }
            const float scl = 1.0f / sa::swap_sum(l);
            if (hi == 0) wsf[32 + r32] = scl;
#pragma unroll
            for (int rd = 0; rd < 2; ++rd) {
#pragma unroll
                for (int gg = 0; gg < 2; ++gg) { const int g = 2 * rd + gg; const f32x4 s4 = *(const LAS f32x4*)(wsf + 32 + 8 * g + 4 * hi);
#pragma unroll
                    for (int d0 = 0; d0 < 4; ++d0)
#pragma unroll
                        for (int j = 0; j < 4; ++j) { const unsigned w2 = o2p[d0][2 * g + (j >> 1)]; const float o2 = (j & 1) ? sa::bf_hi(w2) : sa::bf_lo(w2);
                            stg[(8 * gg + 4 * hi + j) * 128 + d0 * 32 + r32] = o[d0][4 * g + j] * s4[j] - lam * o2; } }
#pragma unroll
                for (int ii = 0; ii < 4; ++ii) { const int row = ii * 4 + (lane >> 4), c8 = lane & 15;
                    const f32x4 a = *(const LAS f32x4*)(stg + row * 128 + c8 * 8), bb = *(const LAS f32x4*)(stg + row * 128 + c8 * 8 + 4);
                    float q = (a[0] * a[0] + a[1] * a[1]) + (a[2] * a[2] + a[3] * a[3]) + (bb[0] * bb[0] + bb[1] * bb[1]) + (bb[2] * bb[2] + bb[3] * bb[3]);
                    q += __shfl_xor(q, 1); q += __shfl_xor(q, 2); q += __shfl_xor(q, 4); q += __shfl_xor(q, 8);
                    const float rn = (1.0f - LAMBDA_INIT) / sqrtf(q * (1.0f / 128.0f) + EPS);
                    const f32x4 g0 = *(const f32x4*)(subg + c8 * 8), g1 = *(const f32x4*)(subg + c8 * 8 + 4);
                    const size_t grow = qrow0 + 16 * rd + row;
                    const u32x4 gt = *(const u32x4*)(PROJ + grow * N1 + C_CG + h * 128 + c8 * 8);
                    u32x4 w; w.x = sa::cvtpk(a[0] * rn * g0[0] * sa::bf_lo(gt.x), a[1] * rn * g0[1] * sa::bf_hi(gt.x)); w.y = sa::cvtpk(a[2] * rn * g0[2] * sa::bf_lo(gt.y), a[3] * rn * g0[3] * sa::bf_hi(gt.y));
                    w.z = sa::cvtpk(bb[0] * rn * g1[0] * sa::bf_lo(gt.z), bb[1] * rn * g1[1] * sa::bf_hi(gt.z)); w.w = sa::cvtpk(bb[2] * rn * g1[2] * sa::bf_lo(gt.w), bb[3] * rn * g1[3] * sa::bf_hi(gt.w));
                    *(u32x4*)(MIX + grow * DM + h * 128 + c8 * 8) = w; }
            }
        }
        asm volatile("s_waitcnt vmcnt(0) lgkmcnt(0)" ::: "memory");
        __syncthreads();
    }
    SEAM(5);

    if (IN(6)) {
        pg8::Gemm g{MIX, WO1T, M_ROWS, DM, DM}; pg8::StaticOrder S; S.init(M_ROWS, DM, G, bx);
        pg8::EpiRes E{out, out, nullptr, nullptr};
        pg8::gemm_phase<pg8::EpiRes, pg8::StaticOrder, true, true>(lds, g, S, E);
    }
#undef IN
#undef SEAM
}

extern "C" void kernel_launch(void* const* d_in, const int* in_sizes, int n_in, void* d_out, int out_size, void* d_ws, size_t ws_size, hipStream_t stream) {
    static int grid = 0;
    if (grid == 0) {
        if (n_in != 20 || in_sizes[0] != M_ROWS * DM || out_size != M_ROWS * DM || ws_size < WS_END) {
            fprintf(stderr, "kernel_launch: unexpected problem (n_in %d, in0 %d, out %d, ws %zu; need ws >= %zu); nothing launched\n", n_in, n_in > 0 ? in_sizes[0] : -1, out_size, ws_size, (size_t)WS_END);
            grid = -1; return; }
        int dev = 0, cus = 0, per_cu = 0;
        if (hipGetDevice(&dev) != hipSuccess || hipDeviceGetAttribute(&cus, hipDeviceAttributeMultiprocessorCount, dev) != hipSuccess) { fprintf(stderr, "kernel_launch: device query failed\n"); grid = -1; return; }
        if (hipFuncSetAttribute((const void*)fwd_kernel, hipFuncAttributeMaxDynamicSharedMemorySize, LDS_BYTES) != hipSuccess) { fprintf(stderr, "kernel_launch: hipFuncSetAttribute failed\n"); grid = -1; return; }
        if (hipOccupancyMaxActiveBlocksPerMultiprocessor(&per_cu, (const void*)fwd_kernel, NWAVES * 64, LDS_BYTES) != hipSuccess || per_cu < 1) {
            fprintf(stderr, "kernel_launch: occupancy query reports %d blocks per CU\n", per_cu); (void)hipGetLastError(); per_cu = 1; }
        grid = cus * 1;
    }
    if (grid < 0) return;
    Args a{};
    for (int i = 0; i < 20; ++i) a.in[i] = (const float*)d_in[i];
    a.out = (float*)d_out; a.ws = (unsigned char*)d_ws;
#if MK_N_LAUNCHES == 1
    a.ph_lo = 0; a.ph_hi = N_PHASES;
    void* kargs[] = {&a};
    hipError_t e = hipLaunchCooperativeKernel((const void*)fwd_kernel, dim3(grid), dim3(NWAVES * 64), kargs, LDS_BYTES, stream);
    if (e != hipSuccess) fprintf(stderr, "kernel_launch: cooperative launch failed: %s (grid %d)\n", hipGetErrorString(e), grid);
#else
    for (int p = 0; p < N_PHASES; ++p) {
        a.ph_lo = p; a.ph_hi = p + 1;
        hipLaunchKernelGGL(fwd_kernel, dim3(grid), dim3(NWAVES * 64), LDS_BYTES, stream, a);
        const hipError_t le = hipPeekAtLastError();
        if (le != hipSuccess) { fprintf(stderr, "kernel_launch: launch %d failed: %s\n", p, hipGetErrorName(le)); break; }
    }
#endif
}
```

```cpp
#include <hip/hip_runtime.h>
#include <cstdio>
#include <cstdint>

#ifndef MK_N_LAUNCHES
#define MK_N_LAUNCHES 1
#endif

#ifndef PROBE_PHASE
#define PROBE_PHASE -1
#endif
#ifndef PROBE_REPS
#define PROBE_REPS 2
#endif

#define LAS __attribute__((address_space(3)))
typedef unsigned short bf16_t;
typedef short bf16x8 __attribute__((ext_vector_type(8)));
typedef short s16x4 __attribute__((ext_vector_type(4)));
typedef float f32x4 __attribute__((ext_vector_type(4)));
typedef float f32x16 __attribute__((ext_vector_type(16)));
typedef unsigned u32x4 __attribute__((ext_vector_type(4)));
typedef unsigned u32x2 __attribute__((ext_vector_type(2)));

constexpr int BATCH = 4, SEQ = 8192, DM = 1024, M_ROWS = BATCH * SEQ;
constexpr int N0 = 3328, N1 = 4096;
constexpr float EPS = 1e-6f;
constexpr float LOG2E = 1.4426950408889634f;
constexpr float C2 = 0.125f * LOG2E;
constexpr float LAMBDA_INIT = 0.35550906759096927f;
constexpr int C_AQ = 0, C_AK = 512, C_AV = 640, C_AG = 768, C_BQ = 1280, C_BK = 1792, C_BV = 2304, C_BG = 2816;
constexpr int C_CQ = 0, C_CK = 1024, C_CV = 2048, C_CG = 3072;

constexpr size_t MiB = 1u << 20;
constexpr size_t WS_W0T = 1 * MiB;
constexpr size_t WS_WO0T = 8 * MiB;
constexpr size_t WS_W1T = 10 * MiB;
constexpr size_t WS_WO1T = 18 * MiB;
constexpr size_t WS_ROPE = 20 * MiB;
constexpr size_t WS_SS = 22 * MiB;
constexpr size_t WS_XN = 32 * MiB;
constexpr size_t WS_MIX = 96 * MiB;
constexpr size_t WS_PROJ = 160 * MiB;
constexpr size_t WS_END = 416 * MiB;

namespace pg8 {
constexpr int BM = 256, BK = 64, HALF = 128, HTB = HALF * BK * 2, STAGE_BYTES = 8 * HTB, NXCD = 8, WGM = 4;
__host__ __device__ __forceinline__ int lds_byte(int r, int c) { const int st = (r >> 4) * 2 + (c >> 5), rr = r & 15, cc = c & 31, ob = rr * 64 + cc * 2; return st * 1024 + (ob ^ (((ob >> 9) & 1) << 5)); }
__host__ __device__ __forceinline__ void stage_rc(int b, int& R, int& C) { const int st = b / 1024, sb = b % 1024, swz = sb ^ (((sb >> 9) & 1) << 5); R = (st >> 1) * 16 + swz / 64; C = (st & 1) * 32 + (swz % 64) / 2; }
__host__ __device__ __forceinline__ int perm32(int rho) { const int n = rho >> 4, i = rho & 15; return 8 * (i >> 2) + 4 * n + (i & 3); }

struct Unit { int pm, pn; };
struct Gemm { const bf16_t* A; const bf16_t* Bt; int M, N, K; };

struct StaticOrder {
    int nM, nN, nwg, G, c;
    __host__ __device__ void init(int M, int N, int G_, int c_) { nM = M / BM; nN = N / BM; nwg = nM * nN; G = G_; c = c_; }
    __host__ __device__ bool next(int i, Unit& u) const {
        const long L = (long)i * G + c; if (L >= nwg) return false;
        int wgid = (int)L; { const int q = nwg / NXCD, r = nwg % NXCD, xcd = wgid % NXCD, off = wgid / NXCD; wgid = (xcd < r ? xcd * (q + 1) : r * (q + 1) + (xcd - r) * q) + off; }
        const int nig = WGM * nN, gid = wgid / nig, fm = gid * WGM, gsz = (nM - fm) < WGM ? (nM - fm) : WGM;
        u.pm = fm + ((wgid % nig) % gsz); u.pn = (wgid % nig) / gsz; return true;
    }
    __device__ __forceinline__ void a_ready(const Unit&) const {}
    __device__ __forceinline__ void done(const Unit&) const {}
};

__device__ __forceinline__ unsigned cvt_pk_bf16(float lo, float hi) { unsigned r; asm volatile("s_nop 0\n\tv_cvt_pk_bf16_f32 %0, %1, %2" : "=v"(r) : "v"(lo), "v"(hi)); return r; }

struct EpiProj {
    static constexpr bool PERM = true, AFTER_DRAIN = false;
    bf16_t* O; int ldc; int layer;
    const float* g_q; const float* g_k; const float* g_q2; const float* g_k2;
    const float* rope;
    const float* ss;
    __device__ __forceinline__ void operator()(const f32x4 (&acc)[2][2][4][2], const Unit& u, int wr, int wc, int fr, int fq) const {
        const int gh = 4 * u.pn + wc;
        const float* gp = nullptr; bool rope_on = false, silu_on = false; float sc = 1.f;
        if (layer == 0) {
            if (gh < 8) { gp = g_q; rope_on = true; sc = C2; } else if (gh < 10) { gp = g_k; rope_on = true; } else if (gh < 12) {} else if (gh < 20) { silu_on = true; }
            else if (gh < 28) { gp = g_q2; sc = C2; } else if (gh < 36) { gp = g_k2; } else if (gh < 44) {} else { silu_on = true; }
        } else {
            if (gh < 16) { gp = g_q; rope_on = true; sc = C2; } else if (gh < 32) { gp = g_k; rope_on = true; } else if (gh < 48) {} else { silu_on = true; }
        }
        f32x4 gv[2][2];
#pragma unroll
        for (int bj = 0; bj < 2; ++bj)
#pragma unroll
            for (int n = 0; n < 2; ++n) gv[bj][n] = gp ? *(const f32x4*)(gp + 32 * bj + 8 * fq + 4 * n) : (f32x4){1.f, 1.f, 1.f, 1.f};
        bf16_t* dbuf = O; int NH = 1, hidx = 0, RP = ldc, coff = u.pn * BM + 64 * wc;
        if (layer == 1) {
            if (gh < 16) { dbuf = O; NH = 16; hidx = gh; RP = 64; coff = 0; }
            else if (gh < 32) { dbuf = O + (size_t)M_ROWS * 1024; NH = 16; hidx = gh - 16; RP = 64; coff = 0; }
            else if (gh < 48) { dbuf = O + (size_t)M_ROWS * 2048; NH = 8; hidx = (gh - 32) >> 1; RP = 128; coff = ((gh - 32) & 1) * 64; }
            else { dbuf = O + (size_t)M_ROWS * 3072; NH = 1; hidx = 0; RP = 1024; coff = (gh - 48) * 64; }
        }
        const int colo = coff + 8 * fq;
        const int row0 = u.pm * BM + wr * 64 + fr;
        float rs[8];
        if (ss) {
            f32x4 p4[8];
#pragma unroll
            for (int g = 0; g < 8; ++g) p4[g] = *(const f32x4*)(ss + (size_t)(row0 + (g >> 2) * HALF + (g & 3) * 16) * 16 + 4 * fq);
#pragma unroll
            for (int g = 0; g < 8; ++g) { float q = (p4[g][0] + p4[g][1]) + (p4[g][2] + p4[g][3]); q += __shfl_xor(q, 16); q += __shfl_xor(q, 32); rs[g] = __builtin_amdgcn_rsqf(q * (1.0f / 1024.0f) + EPS); }
        } else {
#pragma unroll
            for (int g = 0; g < 8; ++g) rs[g] = 1.f;
        }
        f32x4 rc[3][2][2];
        const float* rtab = rope + 8 * fq;
#define EP_ROPE_LD(g) do { const int pos_ = (row0 + ((g) >> 2) * HALF + ((g) & 3) * 16) & (SEQ - 1); _Pragma("unroll") for (int n = 0; n < 2; ++n) { \
            rc[(g) % 3][n][0] = *(const f32x4*)(rtab + (size_t)pos_ * 32 + 4 * n); rc[(g) % 3][n][1] = *(const f32x4*)(rtab + (size_t)SEQ * 32 + (size_t)pos_ * 32 + 4 * n); } } while (0)
        if (rope_on) { EP_ROPE_LD(0); EP_ROPE_LD(1); }
#pragma unroll
        for (int g = 0; g < 8; ++g) {
            const int ai = g >> 2, m = g & 3;
            const int row = row0 + ai * HALF + m * 16;
            const size_t drow = (size_t)((row >> 13) * NH + hidx) * SEQ + (row & (SEQ - 1));
            if (rope_on && g + 2 < 8) EP_ROPE_LD(g + 2);
            f32x4 v[2][2];
#pragma unroll
            for (int bj = 0; bj < 2; ++bj)
#pragma unroll
                for (int n = 0; n < 2; ++n) v[bj][n] = acc[ai][bj][m][n] * rs[g];
            if (gp) {
                float q = 0.f;
#pragma unroll
                for (int bj = 0; bj < 2; ++bj)
#pragma unroll
                    for (int n = 0; n < 2; ++n) { const f32x4 x = v[bj][n]; q += (x[0] * x[0] + x[1] * x[1]) + (x[2] * x[2] + x[3] * x[3]); }
                q += __shfl_xor(q, 16); q += __shfl_xor(q, 32);
                const float rn = __builtin_amdgcn_rsqf(q * (1.0f / 64.0f) + EPS);
#pragma unroll
                for (int bj = 0; bj < 2; ++bj)
#pragma unroll
                    for (int n = 0; n < 2; ++n) v[bj][n] = v[bj][n] * rn * gv[bj][n];
            }
            if (rope_on) {
#pragma unroll
                for (int n = 0; n < 2; ++n) {
                    const f32x4 c = rc[g % 3][n][0], sn = rc[g % 3][n][1];
                    const f32x4 x1 = v[0][n], x2 = v[1][n];
                    v[0][n] = x1 * c - x2 * sn; v[1][n] = x2 * c + x1 * sn;
                }
            }
#pragma unroll
            for (int bj = 0; bj < 2; ++bj) {
                f32x4 a = v[bj][0] * sc, b = v[bj][1] * sc;
                if (silu_on) {
#pragma unroll
                    for (int j = 0; j < 4; ++j) { a[j] = a[j] * __builtin_amdgcn_rcpf(1.0f + __builtin_amdgcn_exp2f(-LOG2E * a[j])); b[j] = b[j] * __builtin_amdgcn_rcpf(1.0f + __builtin_amdgcn_exp2f(-LOG2E * b[j])); }
                }
                u32x4 w; w.x = cvt_pk_bf16(a[0], a[1]); w.y = cvt_pk_bf16(a[2], a[3]); w.z = cvt_pk_bf16(b[0], b[1]); w.w = cvt_pk_bf16(b[2], b[3]);
                *(u32x4*)(dbuf + drow * RP + colo + 32 * bj) = w;
            }
        }
#undef EP_ROPE_LD
    }
};
struct EpiRes {
    static constexpr bool PERM = true, AFTER_DRAIN = false;
    const float* base; const bf16_t* base16; float* out; bf16_t* xb; float* ss;
    __device__ __forceinline__ void operator()(const f32x4 (&acc)[2][2][4][2], const Unit& u, int wr, int wc, int fr, int fq) const {
#pragma unroll
        for (int ai = 0; ai < 2; ++ai)
#pragma unroll
            for (int m = 0; m < 4; ++m) {
                const int row = u.pm * BM + ai * HALF + wr * 64 + m * 16 + fr;
                float q = 0.f;
#pragma unroll
                for (int bj = 0; bj < 2; ++bj) {
                    const size_t off = (size_t)row * DM + u.pn * BM + bj * HALF + wc * 32 + 8 * fq;
                    f32x4 b0, b1;
                    if (base16) { const u32x4 w = *(const u32x4*)(base16 + off);
                        b0 = (f32x4){__uint_as_float(w.x << 16), __uint_as_float(w.x & 0xffff0000u), __uint_as_float(w.y << 16), __uint_as_float(w.y & 0xffff0000u)};
                        b1 = (f32x4){__uint_as_float(w.z << 16), __uint_as_float(w.z & 0xffff0000u), __uint_as_float(w.w << 16), __uint_as_float(w.w & 0xffff0000u)}; }
                    else { b0 = *(const f32x4*)(base + off); b1 = *(const f32x4*)(base + off + 4); }
                    const f32x4 a = acc[ai][bj][m][0] + b0, b = acc[ai][bj][m][1] + b1;
                    if (out) { *(f32x4*)(out + off) = a; *(f32x4*)(out + off + 4) = b; }
                    q += (a[0] * a[0] + a[1] * a[1]) + (a[2] * a[2] + a[3] * a[3]) + (b[0] * b[0] + b[1] * b[1]) + (b[2] * b[2] + b[3] * b[3]);
                    if (xb) { u32x4 w; w.x = cvt_pk_bf16(a[0], a[1]); w.y = cvt_pk_bf16(a[2], a[3]); w.z = cvt_pk_bf16(b[0], b[1]); w.w = cvt_pk_bf16(b[2], b[3]); *(u32x4*)(xb + off) = w; }
                }
                if (ss) { q += __shfl_xor(q, 16); q += __shfl_xor(q, 32); if (fq == 0) ss[(size_t)row * 16 + u.pn * 4 + wc] = q; }
            }
    }
};

template <class Epi, class Sched, bool ALIGN_EPI = false, bool SP2 = false>
__device__ __forceinline__ void gemm_phase(LAS unsigned char* lds, const Gemm g, const Sched& S, const Epi& E) {
    const int tid = threadIdx.x, wid = __builtin_amdgcn_readfirstlane(tid >> 6), lane = tid & 63, wr = wid >> 2, wc = wid & 3, fr = lane & 15, fq = lane >> 4;
    const int K = g.K, nt = K / BK;
    unsigned voffA[2], voffB[2];
#pragma unroll
    for (int i = 0; i < 2; ++i) { int R, C; stage_rc(tid * 16 + i * 8192, R, C); const int Rb = Epi::PERM ? ((R & ~31) + perm32(R & 31)) : R;
        voffA[i] = (unsigned)(R * K + C) * 2u; voffB[i] = (unsigned)(Rb * K + C) * 2u; }
    const size_t kstep = (size_t)(BK * 2);
    const size_t hstep = (size_t)HALF * K * 2;
    const size_t tstep = 2 * hstep;
    const unsigned ldsw = (unsigned)wid * 1024u;
    const int aoff = lds_byte(wr * 64 + fr, fq * 8), boff = lds_byte(wc * 32 + fr, fq * 8);
#define PG8_SA(b, h) (((b) * 2 + (h)) * HTB)
#define PG8_SB(b, h) ((4 + (b) * 2 + (h)) * HTB)
#define PG8_STAGE(bufoff, gbase, voff) do { _Pragma("unroll") for (int _i = 0; _i < 2; ++_i) \
        __builtin_amdgcn_global_load_lds((const unsigned*)((const char*)(gbase) + (voff)[_i]), (LAS unsigned*)(lds + (bufoff) + ldsw + _i * 8192), 16, 0, 0); } while (0)
#define PG8_LDA(dst, b, h) do { _Pragma("unroll") for (int m = 0; m < 4; ++m) _Pragma("unroll") for (int k = 0; k < 2; ++k) dst[m][k] = *(const LAS bf16x8*)(lds + PG8_SA(b, h) + aoff + m * 2048 + k * 1024); } while (0)
#define PG8_LDB(dst, b, h) do { _Pragma("unroll") for (int n = 0; n < 2; ++n) _Pragma("unroll") for (int k = 0; k < 2; ++k) dst[n][k] = *(const LAS bf16x8*)(lds + PG8_SB(b, h) + boff + n * 2048 + k * 1024); } while (0)
#define PG8_MMA(ai, bj, At, Bt) do { __builtin_amdgcn_s_setprio(1); _Pragma("unroll") for (int m = 0; m < 4; ++m) _Pragma("unroll") for (int n = 0; n < 2; ++n) _Pragma("unroll") for (int k = 0; k < 2; ++k) \
        acc[ai][bj][m][n] = __builtin_amdgcn_mfma_f32_16x16x32_bf16(Bt[n][k], At[m][k], acc[ai][bj][m][n], 0, 0, 0); __builtin_amdgcn_s_setprio(0); } while (0)
#define PG8_WAIT_V(n) asm volatile("s_waitcnt vmcnt(" #n ")" ::: "memory")
#define PG8_WAIT_L(n) asm volatile("s_waitcnt lgkmcnt(" #n ")" ::: "memory")
#define PG8_BAR __builtin_amdgcn_s_barrier()
#define PG8_SCHED __builtin_amdgcn_sched_barrier(0)
    Unit cur, nxt; int ui = 0;
    if (!S.next(0, cur)) return;
    f32x4 acc[2][2][4][2];
#pragma unroll
    for (int a = 0; a < 2; ++a)
#pragma unroll
        for (int b = 0; b < 2; ++b)
#pragma unroll
            for (int m = 0; m < 4; ++m)
#pragma unroll
                for (int n = 0; n < 2; ++n) acc[a][b][m][n] = (f32x4){0.f, 0.f, 0.f, 0.f};
    bf16x8 At[4][2], B0[2][2], B1[2][2];
    const char* cA = (const char*)g.A + (size_t)cur.pm * tstep; const char* cB = (const char*)g.Bt + (size_t)cur.pn * tstep;
    S.a_ready(cur);
    if constexpr (SP2) {
        PG8_STAGE(PG8_SB(0, 0), cB, voffB); PG8_STAGE(PG8_SB(0, 1), cB + hstep, voffB); PG8_STAGE(PG8_SA(0, 0), cA, voffA); PG8_STAGE(PG8_SA(0, 1), cA + hstep, voffA);
        if (wr == 1) PG8_BAR;
        PG8_WAIT_V(2); PG8_BAR;
        PG8_STAGE(PG8_SB(1, 0), cB + kstep, voffB); PG8_STAGE(PG8_SA(1, 0), cA + kstep, voffA); PG8_STAGE(PG8_SB(1, 1), cB + hstep + kstep, voffB);
        PG8_WAIT_V(6); PG8_BAR;
    } else {
        PG8_STAGE(PG8_SB(0, 0), cB, voffB); PG8_STAGE(PG8_SA(0, 0), cA, voffA); PG8_STAGE(PG8_SB(0, 1), cB + hstep, voffB); PG8_STAGE(PG8_SA(0, 1), cA + hstep, voffA);
        if (wr == 1) PG8_BAR;
        PG8_WAIT_V(4); PG8_BAR;
        PG8_STAGE(PG8_SB(1, 0), cB + kstep, voffB); PG8_STAGE(PG8_SA(1, 0), cA + kstep, voffA); PG8_STAGE(PG8_SB(1, 1), cB + hstep + kstep, voffB);
        PG8_WAIT_V(6); PG8_BAR;
    }
    for (;;) {
        const bool has_next = S.next(ui + 1, nxt);
        const char* nA = has_next ? (const char*)g.A + (size_t)nxt.pm * tstep : cA; const char* nB = has_next ? (const char*)g.Bt + (size_t)nxt.pn * tstep : cB;
        for (int t = 0; t < nt; t += 2) {
            const bool last = (t == nt - 2);
            const char* a1 = cA + (size_t)(t + 1) * kstep;
            const char* a2 = last ? nA : cA + (size_t)(t + 2) * kstep; const char* b2 = last ? nB : cB + (size_t)(t + 2) * kstep;
            const char* a3 = a2 + kstep; const char* b3 = b2 + kstep;
            if (last && has_next) S.a_ready(nxt);
            if constexpr (SP2) {
            PG8_LDB(B0, 0, 0); PG8_LDB(B1, 0, 1); PG8_SCHED; PG8_LDA(At, 0, 0); PG8_STAGE(PG8_SA(1, 1), a1 + hstep, voffA);
            PG8_WAIT_V(8); PG8_WAIT_L(0); PG8_BAR; PG8_MMA(0, 0, At, B0); PG8_MMA(0, 1, At, B1); PG8_BAR; PG8_SCHED;
            PG8_LDA(At, 0, 1); PG8_STAGE(PG8_SB(0, 0), b2, voffB); PG8_STAGE(PG8_SB(0, 1), b2 + hstep, voffB); PG8_STAGE(PG8_SA(0, 0), a2, voffA);
            PG8_WAIT_V(8); PG8_WAIT_L(0); PG8_BAR; PG8_MMA(1, 0, At, B0); PG8_MMA(1, 1, At, B1); PG8_BAR; PG8_SCHED;
            PG8_LDB(B0, 1, 0); PG8_LDB(B1, 1, 1); PG8_SCHED; PG8_LDA(At, 1, 0); PG8_STAGE(PG8_SA(0, 1), a2 + hstep, voffA);
            PG8_WAIT_V(8); PG8_WAIT_L(0); PG8_BAR; PG8_MMA(0, 0, At, B0); PG8_MMA(0, 1, At, B1); PG8_BAR; PG8_SCHED;
            PG8_LDA(At, 1, 1); PG8_STAGE(PG8_SB(1, 0), b3, voffB); PG8_STAGE(PG8_SB(1, 1), b3 + hstep, voffB); PG8_STAGE(PG8_SA(1, 0), a3, voffA);
            PG8_WAIT_V(8); PG8_WAIT_L(0); PG8_BAR; PG8_MMA(1, 0, At, B0); PG8_MMA(1, 1, At, B1); PG8_BAR; PG8_SCHED;
            } else {
            PG8_LDB(B0, 0, 0); PG8_SCHED; PG8_LDA(At, 0, 0); PG8_STAGE(PG8_SA(1, 1), a1 + hstep, voffA);
            PG8_WAIT_L(8); PG8_BAR; PG8_WAIT_L(0); PG8_MMA(0, 0, At, B0); PG8_BAR; PG8_SCHED;
            PG8_LDB(B1, 0, 1); PG8_STAGE(PG8_SB(0, 0), b2, voffB);
            PG8_BAR; PG8_WAIT_L(0); PG8_MMA(0, 1, At, B1); PG8_BAR;
            PG8_LDA(At, 0, 1); PG8_STAGE(PG8_SA(0, 0), a2, voffA);
            PG8_BAR; PG8_WAIT_L(0); PG8_MMA(1, 0, At, B0); PG8_BAR; PG8_SCHED;
            PG8_STAGE(PG8_SB(0, 1), b2 + hstep, voffB);
            PG8_WAIT_V(6); PG8_BAR; PG8_MMA(1, 1, At, B1); PG8_BAR;
            PG8_LDB(B0, 1, 0); PG8_SCHED; PG8_LDA(At, 1, 0); PG8_STAGE(PG8_SA(0, 1), a2 + hstep, voffA);
            PG8_WAIT_L(8); PG8_BAR; PG8_WAIT_L(0); PG8_MMA(0, 0, At, B0); PG8_BAR; PG8_SCHED;
            PG8_LDB(B1, 1, 1); PG8_STAGE(PG8_SB(1, 0), b3, voffB);
            PG8_BAR; PG8_WAIT_L(0); PG8_MMA(0, 1, At, B1); PG8_BAR;
            PG8_LDA(At, 1, 1); PG8_STAGE(PG8_SA(1, 0), a3, voffA);
            PG8_BAR; PG8_WAIT_L(0); PG8_MMA(1, 0, At, B0); PG8_BAR; PG8_SCHED;
            PG8_STAGE(PG8_SB(1, 1), b3 + hstep, voffB);
            PG8_WAIT_V(6); PG8_BAR; PG8_MMA(1, 1, At, B1); PG8_BAR;
            }
        }
        if constexpr (ALIGN_EPI) { if (wr == 0) PG8_BAR; }
        if constexpr (!Epi::AFTER_DRAIN) { E(acc, cur, wr, wc, fr, fq); S.done(cur); }
        if (!has_next) break;
#pragma unroll
        for (int a = 0; a < 2; ++a)
#pragma unroll
            for (int b = 0; b < 2; ++b)
#pragma unroll
                for (int m = 0; m < 4; ++m)
#pragma unroll
                    for (int n = 0; n < 2; ++n) acc[a][b][m][n] = (f32x4){0.f, 0.f, 0.f, 0.f};
        cur = nxt; cA = nA; cB = nB; ++ui;
        if constexpr (ALIGN_EPI) { if (wr == 1) PG8_BAR; }
    }
    PG8_WAIT_V(0);
    if constexpr (!ALIGN_EPI) { if (wr == 0) PG8_BAR; }
    PG8_BAR;
#undef PG8_SA
#undef PG8_SB
#undef PG8_STAGE
#undef PG8_LDA
#undef PG8_LDB
#undef PG8_MMA
#undef PG8_WAIT_V
#undef PG8_WAIT_L
#undef PG8_BAR
#undef PG8_SCHED
}
}

namespace sa {
typedef LAS const char* lds_cptr;
typedef short v4i16_t __attribute__((ext_vector_type(4)));
__device__ __forceinline__ unsigned cvtpk(float lo, float hi) { unsigned r; asm("s_nop 0\n\tv_cvt_pk_bf16_f32 %0, %1, %2" : "=v"(r) : "v"(lo), "v"(hi)); return r; }
__device__ __forceinline__ void glds16(const void* g, unsigned lds_base) {
    unsigned sv; asm volatile("s_mov_b32 %0, m0\n\ts_mov_b32 m0, %2\n\ts_nop 0\n\tglobal_load_lds_dwordx4 %1, off\n\ts_mov_b32 m0, %0" : "=&s"(sv) : "v"(g), "s"(lds_base) : "memory"); }
__device__ __forceinline__ s16x4 vtr(lds_cptr p) { return __builtin_bit_cast(s16x4, __builtin_amdgcn_ds_read_tr16_b64_v4i16((LAS v4i16_t*)p)); }
__device__ __forceinline__ void glds16s(unsigned voff, const void* sbase, unsigned lds_base) {
    unsigned sv; asm volatile("s_mov_b32 %0, m0\n\ts_mov_b32 m0, %3\n\ts_nop 4\n\tglobal_load_lds_dwordx4 %1, %2\n\ts_mov_b32 m0, %0" : "=&s"(sv) : "v"(voff), "s"(sbase), "s"(lds_base) : "memory"); }
__device__ __forceinline__ float max3f(float a, float b, float c) { float r; asm("v_max3_f32 %0, %1, %2, %3" : "=v"(r) : "v"(a), "v"(b), "v"(c)); return r; }
__device__ __forceinline__ unsigned cvtpk_c(float lo, float hi) { typedef float f2 __attribute__((ext_vector_type(2))); typedef __bf16 b2 __attribute__((ext_vector_type(2))); f2 v = {lo, hi}; b2 b = __builtin_convertvector(v, b2); return __builtin_bit_cast(unsigned, b); }
#define SA_MFMA(a, b, c) __builtin_amdgcn_mfma_f32_32x32x16_bf16(a, b, c, 0, 0, 0)
#define SA_WAIT_BAR() asm volatile("s_waitcnt vmcnt(0) lgkmcnt(0)\n\ts_barrier" ::: "memory")
__device__ __forceinline__ float swap_sum(float v) { auto rr = __builtin_amdgcn_permlane32_swap(__float_as_uint(v), __float_as_uint(v), false, false); return __uint_as_float(rr[0]) + __uint_as_float(rr[1]); }
__device__ __forceinline__ float swap_max(float v) { auto rr = __builtin_amdgcn_permlane32_swap(__float_as_uint(v), __float_as_uint(v), false, false); return fmaxf(__uint_as_float(rr[0]), __uint_as_float(rr[1])); }
__device__ __forceinline__ float bf_lo(unsigned w) { return __uint_as_float(w << 16); }
__device__ __forceinline__ float bf_hi(unsigned w) { return __uint_as_float(w & 0xffff0000u); }

template <int NDB> struct Lay {
    static constexpr int NSLOT = 3, SLOT_K = 8192, SLOT_V = NDB * 4096, SLOT = SLOT_K + SLOT_V;
    static constexpr int WSF = NSLOT * SLOT, TAB = WSF + 2048, STG = TAB + 1280, STG_W = 8192, END = STG + 8 * STG_W;
};
constexpr float THR = 8.0f;

template <int NDB, int MODE>
__device__ __forceinline__ void stream(LAS char* lds, const bf16_t* Qw, int pq, const bf16_t* Kh, int pk, const bf16_t* Vh, int pv, int t_lo, int t_hi, int w_lo, int w_hi,
                                       int cw, int qi0, f32x16 (&o)[NDB], float& m, float& l) {
    typedef Lay<NDB> L;
    const int tid = threadIdx.x, lane = tid & 63, r32 = lane & 31, hi = lane >> 5; const int wid = __builtin_amdgcn_readfirstlane(tid >> 6);
    const unsigned lds0 = (unsigned)(size_t)lds;
    LAS float* wsf = (LAS float*)(lds + L::WSF) + wid * 64;
    const LAS float* tab = (const LAS float*)(lds + L::TAB);
    const bf16_t* ksrc = Kh + (size_t)lane * pk + wid * 8;
    auto issue = [&](int t, int slot) {
        glds16(ksrc + (size_t)t * 64 * pk, (unsigned)__builtin_amdgcn_readfirstlane(lds0 + slot * L::SLOT + wid * 1024));
#pragma unroll
        for (int j = 0; j < NDB / 2; ++j) { const int pc = wid + 8 * j;
            const bf16_t* vsrc = Vh + (size_t)(t * 64 + 16 * (pc & 3) + (lane >> 2)) * pv + (pc >> 2) * 32 + (lane & 3) * 8;
            glds16(vsrc, (unsigned)__builtin_amdgcn_readfirstlane(lds0 + slot * L::SLOT + L::SLOT_K + pc * 1024)); }
    };
    bf16x8 qr[4];
#pragma unroll
    for (int d0 = 0; d0 < 4; ++d0) qr[d0] = *(const bf16x8*)(Qw + (size_t)r32 * pq + d0 * 16 + hi * 8);
    issue(t_lo, 0);
    if (t_lo + 1 < t_hi) issue(t_lo + 1, 1);
#pragma unroll
    for (int d0 = 0; d0 < NDB; ++d0) o[d0] = f32x16{};
    m = 0.f; l = 0.f;
    f32x16 negm = f32x16{};
    if (t_lo + 1 < t_hi) { if (NDB == 4) asm volatile("s_waitcnt vmcnt(3) lgkmcnt(0)\n\ts_barrier" ::: "memory"); else asm volatile("s_waitcnt vmcnt(2) lgkmcnt(0)\n\ts_barrier" ::: "memory"); }
    else SA_WAIT_BAR();
    int cur = 0;
    for (int t = t_lo; t < t_hi; ++t) {
        const int nx2 = cur == 0 ? 2 : cur - 1;
        const bool more = t + 2 < t_hi;
        if (more) issue(t + 2, nx2);
        if (t >= w_lo && t <= w_hi) {
            const lds_cptr kb = (lds_cptr)lds + cur * L::SLOT + hi * 1024 + r32 * 16;
            f32x16 p0, p1;
#pragma unroll
            for (int d0 = 0; d0 < 4; ++d0) {
                const bf16x8 b0 = *(const LAS bf16x8*)(kb + d0 * 2048), b1 = *(const LAS bf16x8*)(kb + d0 * 2048 + 512);
                if (d0 == 0) { p0 = SA_MFMA(b0, qr[0], negm); p1 = SA_MFMA(b1, qr[0], negm); }
                else { p0 = SA_MFMA(b0, qr[d0], p0); p1 = SA_MFMA(b1, qr[d0], p1); }
            }
            if (MODE == 1) {
                const int dist = cw - t;
                if (dist >= 3) { const float cb = tab[256];
#pragma unroll
                    for (int r = 0; r < 16; ++r) { p0[r] += cb; p1[r] += cb; } }
                else { const int ib = dist * 64 + qi0 + r32 + 128 - 4 * hi;
#pragma unroll
                    for (int r = 0; r < 16; ++r) { const int k = (r & 3) + 8 * (r >> 2); int i0 = ib - k, i1 = ib - k - 32; i0 = i0 > 256 ? 256 : i0; i1 = i1 > 256 ? 256 : i1; p0[r] += tab[i0]; p1[r] += tab[i1]; } }
            }
            float rm = fmaxf(p0[0], p1[0]);
#pragma unroll
            for (int r = 1; r < 16; ++r) rm = fmaxf(rm, fmaxf(p0[r], p1[r]));
            rm = swap_max(rm);
            const bool first = (t == w_lo);
            if (first || __any(rm > THR)) {
                const float dl = first ? rm : fmaxf(rm, 0.f), al = first ? 1.f : __builtin_amdgcn_exp2f(-dl); l *= al; m += dl;
#pragma unroll
                for (int r = 0; r < 16; ++r) { p0[r] -= dl; p1[r] -= dl; negm[r] = -m; }
                if (hi == 0) wsf[r32] = al;
#pragma unroll
                for (int g = 0; g < 4; ++g) { const f32x4 a4 = *(const LAS f32x4*)(wsf + 8 * g + 4 * hi);
#pragma unroll
                    for (int d0 = 0; d0 < NDB; ++d0)
#pragma unroll
                        for (int j = 0; j < 4; ++j) o[d0][4 * g + j] *= a4[j]; }
            }
            float sum = 0.f;
#pragma unroll
            for (int r = 0; r < 16; ++r) { p0[r] = __builtin_amdgcn_exp2f(p0[r]); p1[r] = __builtin_amdgcn_exp2f(p1[r]); sum += p0[r] + p1[r]; }
            l += sum;
            u32x4 pw[4];
#pragma unroll
            for (int j = 0; j < 4; ++j) { pw[0][j] = cvtpk(p0[2 * j], p0[2 * j + 1]); pw[1][j] = cvtpk(p0[8 + 2 * j], p0[9 + 2 * j]); pw[2][j] = cvtpk(p1[2 * j], p1[2 * j + 1]); pw[3][j] = cvtpk(p1[8 + 2 * j], p1[9 + 2 * j]); }
            const lds_cptr vp = (lds_cptr)lds + cur * L::SLOT + L::SLOT_K + ((lane >> 4) & 1) * 32 + (lane & 3) * 8 + (4 * hi + ((lane & 15) >> 2)) * 64;
#pragma unroll
            for (int d0 = 0; d0 < NDB; ++d0) {
#pragma unroll
                for (int ks = 0; ks < 4; ++ks) {
                    const s16x4 lo = vtr(vp + d0 * 4096 + ks * 1024), hh = vtr(vp + d0 * 4096 + ks * 1024 + 512);
                    const bf16x8 vf = (bf16x8){lo[0], lo[1], lo[2], lo[3], hh[0], hh[1], hh[2], hh[3]};
                    o[d0] = SA_MFMA(__builtin_bit_cast(bf16x8, pw[ks]), vf, o[d0]);
                }
            }
        }
        if (more) { if (NDB == 4) asm volatile("s_waitcnt vmcnt(3) lgkmcnt(0)\n\ts_barrier" ::: "memory"); else asm volatile("s_waitcnt vmcnt(2) lgkmcnt(0)\n\ts_barrier" ::: "memory"); }
        else SA_WAIT_BAR();
        cur = cur == 2 ? 0 : cur + 1;
    }
}

template <int NDB> struct PPIssue {
    typedef Lay<NDB> L;
    unsigned lds0, kvoff, vvoff[NDB / 2]; int wid, pk, pv, T; const bf16_t* Kh; const bf16_t* Vh;
    __device__ __forceinline__ void init(LAS char* lds, const bf16_t* Kh_, int pk_, const bf16_t* Vh_, int pv_, int T_) {
        const int tid = threadIdx.x, lane = tid & 63; wid = __builtin_amdgcn_readfirstlane(tid >> 6);
        lds0 = (unsigned)(size_t)lds; Kh = Kh_; Vh = Vh_; pk = pk_; pv = pv_; T = T_;
        kvoff = (unsigned)(((8 * wid + (lane >> 3)) * pk + (((lane & 7) ^ ((4 * wid + (lane >> 4)) & 7)) * 8)) * 2);
#pragma unroll
        for (int j = 0; j < NDB / 2; ++j) { const int pc = wid + 8 * j; vvoff[j] = (unsigned)(((16 * (pc & 3) + (lane >> 2)) * pv + (pc >> 2) * 32 + (lane & 3) * 8) * 2); }
    }
    __device__ __forceinline__ void issue(int gt, int slot) const {
        const int kt = gt < T ? gt : T - 1, vt = gt >= 1 ? gt - 1 : 0;
        glds16s(kvoff, Kh + (size_t)kt * 64 * pk, (unsigned)__builtin_amdgcn_readfirstlane(lds0 + slot * L::SLOT + wid * 1024));
#pragma unroll
        for (int j = 0; j < NDB / 2; ++j) { const int pc = wid + 8 * j;
            glds16s(vvoff[j], Vh + (size_t)vt * 64 * pv, (unsigned)__builtin_amdgcn_readfirstlane(lds0 + slot * L::SLOT + L::SLOT_K + pc * 1024)); }
    }
};
template <int NDB>
__device__ __forceinline__ void pp_prefetch(LAS char* lds, const bf16_t* Qw, int pq, const bf16_t* Kh, int pk, const bf16_t* Vh, int pv, int T, bf16x8 (&qr)[4]) {
    const int lane = threadIdx.x & 63, r32 = lane & 31, hi = lane >> 5;
    PPIssue<NDB> I; I.init(lds, Kh, pk, Vh, pv, T);
#pragma unroll
    for (int d0 = 0; d0 < 4; ++d0) qr[d0] = *(const bf16x8*)(Qw + (size_t)r32 * pq + d0 * 16 + hi * 8);
    I.issue(0, 0); I.issue(1, 1);
}
template <int NDB, bool NOREF, int MODE>
__device__ __forceinline__ void stream_pp(LAS char* lds, const bf16_t* Kh, int pk, const bf16_t* Vh, int pv, int T, int w_lo, int w_hi, int cwr, int qi0, const bf16x8 (&qr)[4],
                                          f32x16 (&o)[NDB], float& l, float& m) {
    typedef Lay<NDB> L;
    static_assert(NDB == 4 || NDB == 2, "a group is 1 K + NDB/2 V pieces per wave: the counted waits below leave exactly one group in flight");
    constexpr int NF = 8 + 4 * NDB;
    const LAS float* tab = (const LAS float*)(lds + L::TAB);
    const int tid = threadIdx.x, lane = tid & 63, r32 = lane & 31, hi = lane >> 5; const int wid = __builtin_amdgcn_readfirstlane(tid >> 6);
    const int role = wid >> 2;
    LAS float* wsf = (LAS float*)(lds + L::WSF) + wid * 64;
    PPIssue<NDB> I; I.init(lds, Kh, pk, Vh, pv, T);
    auto issue = [&](int gt, int slot) { I.issue(gt, slot); };
#pragma unroll
    for (int d0 = 0; d0 < NDB; ++d0) o[d0] = f32x16{};
    m = 0.f; l = 0.f;
    f32x16 p0 = f32x16{}, p1 = f32x16{};
    u32x4 pw[4] = {};
    constexpr int PP_D = 6; bf16x8 fr[PP_D];
#define PP_WAITN() do { if (NDB == 4) asm volatile("s_waitcnt vmcnt(3) lgkmcnt(0)\n\ts_barrier" ::: "memory"); else asm volatile("s_waitcnt vmcnt(2) lgkmcnt(0)\n\ts_barrier" ::: "memory"); } while (0)
    PP_WAITN();
    __builtin_amdgcn_sched_barrier(0);
    int slot_m = 0;
    int slot_i = 2;
    const int kx0 = r32 * 128 + ((hi ^ ((r32 >> 1) & 7)) * 16);
    const lds_cptr vp0 = (lds_cptr)lds + L::SLOT_K + ((lane >> 4) & 1) * 32 + (lane & 3) * 8 + (4 * hi + ((lane & 15) >> 2)) * 64;
#define PP_ISSUE(t) do { if ((t) + 2 <= T) { issue((t) + 2, slot_i); slot_i = slot_i == 2 ? 0 : slot_i + 1; } } while (0)
#define PP_BAR_EVEN() do { __builtin_amdgcn_sched_barrier(0); } while (0)
#define PP_BAR_ODD(t) do { __builtin_amdgcn_sched_barrier(0); if ((t) + 2 <= T) PP_WAITN(); else SA_WAIT_BAR(); \
        __builtin_amdgcn_sched_barrier(0); slot_m = slot_m == 2 ? 0 : slot_m + 1; } while (0)
#define PP_SB() __builtin_amdgcn_sched_barrier(0)
#define PP_FRD(i) do { if ((i) < 8) { const int d0_ = (i) >> 1; fr[(i) % PP_D] = *(const LAS bf16x8*)((lds_cptr)lds + slot_m * L::SLOT + (kx0 ^ (d0_ * 32)) + ((i) & 1) * 4096); } \
        else { const lds_cptr vp_ = vp0 + slot_m * L::SLOT + (((i) - 8) >> 2) * 4096 + (((i) - 8) & 3) * 1024; const s16x4 lo_ = vtr(vp_), hh_ = vtr(vp_ + 512); \
               fr[(i) % PP_D] = (bf16x8){lo_[0], lo_[1], lo_[2], lo_[3], hh_[0], hh_[1], hh_[2], hh_[3]}; } } while (0)
#define PP_FMA(i) do { if ((i) < 8) { if ((i) & 1) p1 = SA_MFMA(fr[(i) % PP_D], qr[(i) >> 1], p1); else p0 = SA_MFMA(fr[(i) % PP_D], qr[(i) >> 1], p0); } \
        else o[((i) - 8) >> 2] = SA_MFMA(__builtin_bit_cast(bf16x8, pw[((i) - 8) & 3]), fr[(i) % PP_D], o[((i) - 8) >> 2]); } while (0)
#define PP_PIPE(lo, hi) do { \
        _Pragma("unroll") for (int i_ = (lo); i_ < (lo) + PP_D && i_ < (hi); ++i_) PP_FRD(i_); \
        if ((lo) < 8) { if (NOREF) { p0 = f32x16{}; p1 = f32x16{}; } else { _Pragma("unroll") for (int r = 0; r < 16; ++r) { p0[r] = -m; p1[r] = -m; } } } \
        PP_SB(); \
        _Pragma("unroll") for (int i_ = (lo); i_ < (hi); ++i_) { PP_FMA(i_); if (i_ + PP_D < (hi)) PP_FRD(i_ + PP_D); PP_SB(); } \
        if ((lo) < 8) asm volatile("" : "+v"(p0), "+v"(p1)); } while (0)
#define PP_QK() PP_PIPE(0, 8)
#define PP_PV() PP_PIPE(8, NF)
#define PP_QKPV() PP_PIPE(0, NF)
#define PP_SOFT(first, ts) do { \
        if (MODE == 1) { const int dist_ = cwr - (ts); \
            if (dist_ < 3) {     \
                const LAS float* fb_ = tab + (dist_ * 64 + qi0 + r32 + 128 - 4 * hi - 59);     \
                _Pragma("unroll") for (int r = 0; r < 16; ++r) { const int k_ = (r & 3) + 8 * (r >> 2); p0[r] += fb_[59 - k_]; p1[r] += fb_[27 - k_]; } } } \
        if (!NOREF) { \
        asm volatile("s_nop 15\n\ts_nop 3" : "+v"(p0), "+v"(p1));     \
        float rm = max3f(p0[0], p1[0], p0[1]), rm2 = max3f(p1[1], p0[2], p1[2]); \
        _Pragma("unroll") for (int r = 3; r < 15; r += 2) { rm = max3f(rm, p0[r], p1[r]); rm2 = max3f(rm2, p0[r + 1], p1[r + 1]); } \
        rm = max3f(rm, p0[15], p1[15]); rm = fmaxf(rm, rm2); \
        rm = swap_max(rm); \
        if ((first) || __any(rm > THR)) { \
            const float dl = (first) ? rm : fmaxf(rm, 0.f), al = (first) ? 1.f : __builtin_amdgcn_exp2f(-dl); l *= al; m += dl; \
            _Pragma("unroll") for (int r = 0; r < 16; ++r) { p0[r] -= dl; p1[r] -= dl; } \
            if (hi == 0) wsf[r32] = al; \
            _Pragma("unroll") for (int gq = 0; gq < 4; ++gq) { const f32x4 a4 = *(const LAS f32x4*)(wsf + 8 * gq + 4 * hi); \
                _Pragma("unroll") for (int d0 = 0; d0 < NDB; ++d0) _Pragma("unroll") for (int j = 0; j < 4; ++j) o[d0][4 * gq + j] *= a4[j]; } } } \
        float sum = 0.f; \
        _Pragma("unroll") for (int r = 0; r < 16; ++r) { p0[r] = __builtin_amdgcn_exp2f(p0[r]); p1[r] = __builtin_amdgcn_exp2f(p1[r]); sum += p0[r] + p1[r]; } \
        l += sum; \
        _Pragma("unroll") for (int j = 0; j < 4; ++j) { pw[0][j] = cvtpk_c(p0[2 * j], p0[2 * j + 1]); pw[1][j] = cvtpk_c(p0[8 + 2 * j], p0[9 + 2 * j]); pw[2][j] = cvtpk_c(p1[2 * j], p1[2 * j + 1]); pw[3][j] = cvtpk_c(p1[8 + 2 * j], p1[9 + 2 * j]); } \
        asm volatile("" : "+v"(pw[0]), "+v"(pw[1]), "+v"(pw[2]), "+v"(pw[3]), "+v"(l));     \
        } while (0)
    if (role == 0) {
#pragma clang loop unroll(disable)
        for (int t = 0; t < w_lo; ++t) { PP_ISSUE(t); PP_BAR_ODD(t); }
        { const int t = w_lo; PP_QK(); PP_BAR_EVEN(); PP_ISSUE(t); PP_SOFT(true, t); PP_BAR_ODD(t); }
#pragma clang loop unroll(disable)
        for (int t = w_lo + 1; t <= w_hi; ++t) {
            PP_QKPV(); PP_BAR_EVEN(); PP_ISSUE(t); PP_SOFT(false, t); PP_BAR_ODD(t);
        }
        { const int t = w_hi + 1; PP_PV(); PP_BAR_EVEN(); PP_ISSUE(t); PP_BAR_ODD(t); }
#pragma clang loop unroll(disable)
        for (int t = w_hi + 2; t <= T; ++t) { PP_ISSUE(t); PP_BAR_EVEN(); PP_BAR_ODD(t); }
    } else {
#pragma clang loop unroll(disable)
        for (int t = 0; t < w_lo; ++t) { PP_ISSUE(t); PP_BAR_ODD(t); }
        { const int t = w_lo; PP_ISSUE(t); PP_BAR_EVEN(); PP_QK(); PP_BAR_ODD(t); }
#pragma clang loop unroll(disable)
        for (int t = w_lo + 1; t <= w_hi; ++t) {
            PP_ISSUE(t); PP_SOFT(t - 1 == w_lo, t - 1); PP_BAR_EVEN(); PP_QKPV(); PP_BAR_ODD(t);
        }
        { const int t = w_hi + 1; PP_ISSUE(t); PP_SOFT(t - 1 == w_lo, t - 1); PP_BAR_EVEN(); PP_PV(); PP_BAR_ODD(t); }
#pragma clang loop unroll(disable)
        for (int t = w_hi + 2; t <= T; ++t) { PP_ISSUE(t); PP_BAR_EVEN(); PP_BAR_ODD(t); }
    }
#undef PP_ISSUE
#undef PP_WAITN
#undef PP_BAR_EVEN
#undef PP_BAR_ODD
#undef PP_QK
#undef PP_SB
#undef PP_QKPV
#undef PP_FRD
#undef PP_FMA
#undef PP_PIPE
#undef PP_PV
#undef PP_SOFT
}
}

#define XB_TMO      128
#define XB_XCNT(j)  (256  + 64 * (j))
#define XB_XSUB(j)  (1280 + 64 * (j))
#define XB_XGEN(j)  (2304 + 64 * (j))
#define XB_TOP      3328
#define XB_TOPGEN   3392
#define XCD_BAR_WORDS 3456
#define XB_SPIN_CAP (1u << 18)
__device__ __forceinline__ unsigned xb_ld(unsigned* p)              { return __hip_atomic_load(p, __ATOMIC_RELAXED, __HIP_MEMORY_SCOPE_AGENT); }
__device__ __forceinline__ unsigned xb_add(unsigned* p, unsigned v) { return __hip_atomic_fetch_add(p, v, __ATOMIC_RELAXED, __HIP_MEMORY_SCOPE_AGENT); }
__device__ __forceinline__ unsigned xb_xcc_id() { return (unsigned)__builtin_amdgcn_s_getreg((3 << 11) | 20) & 0xFu; }
#define XB_SPIN(cond, bar) do { unsigned _sp = 0; while (cond) { __builtin_amdgcn_s_sleep(1); \
    if ((++_sp & 255u) == 0u) { if (xb_ld(&(bar)[XB_TMO])) break; if (_sp > XB_SPIN_CAP) { atomicAdd(&(bar)[XB_TMO], 1u); break; } } } } while (0)
struct XcdBarrier { unsigned* bar; unsigned x; volatile LAS unsigned* st; };
__device__ __forceinline__ XcdBarrier xcd_barrier_post(unsigned* bar, volatile LAS unsigned* st) {
    XcdBarrier b; b.bar = bar; b.x = xb_xcc_id(); b.st = st;
    if (threadIdx.x == 0) (void)xb_add(&bar[XB_XCNT(b.x)], 1u);
    return b;
}
__device__ __forceinline__ void xcd_barrier_complete(unsigned* bar, unsigned x, unsigned& nloc, unsigned& nx) {
    const unsigned G = gridDim.x * gridDim.y * gridDim.z;
    unsigned sum, cnt, mine, sp = 0u;
    for (;;) {
        sum = 0u; cnt = 0u; mine = 0u;
#pragma unroll
        for (unsigned j = 0; j < 16; ++j) { const unsigned c = xb_ld(&bar[XB_XCNT(j)]); sum += c; cnt += (c > 0u) ? 1u : 0u; mine = (j == x) ? c : mine; }
        if (sum == G) break;
        __builtin_amdgcn_s_sleep(1);
        if ((++sp & 255u) == 0u) { if (xb_ld(&bar[XB_TMO])) break; if (sp > XB_SPIN_CAP) { atomicAdd(&bar[XB_TMO], 1u); break; } }
    }
    nloc = mine > 0u ? mine : 1u; nx = cnt > 0u ? cnt : 1u;
}
__device__ __forceinline__ void xcd_barrier(const XcdBarrier& b) {
    asm volatile("s_waitcnt vmcnt(0)" ::: "memory");
    __syncthreads();
    if (threadIdx.x == 0) {
        unsigned* bar = b.bar;
        __builtin_amdgcn_s_waitcnt(0);
        unsigned nloc = b.st[0], nx = b.st[1];
        if (nloc == 0u) { xcd_barrier_complete(bar, b.x, nloc, nx); b.st[0] = nloc; b.st[1] = nx; }
        const unsigned old = xb_add(&bar[XB_XSUB(b.x)], 1u);
        const unsigned gen = old / nloc;
        if (old + 1u == (gen + 1u) * nloc) {
            __builtin_amdgcn_fence(__ATOMIC_RELEASE, "agent");
            asm volatile("s_waitcnt vmcnt(0)" ::: "memory");
            const unsigned og = xb_add(&bar[XB_TOP], 1u);
            const unsigned tg = og / nx;
            if (og + 1u == (tg + 1u) * nx) xb_add(&bar[XB_TOPGEN], 1u);
            else XB_SPIN(xb_ld(&bar[XB_TOPGEN]) == tg, bar);
            __builtin_amdgcn_fence(__ATOMIC_ACQUIRE, "agent");
            xb_add(&bar[XB_XGEN(b.x)], 1u);
            asm volatile("s_waitcnt vmcnt(0)" ::: "memory");
        } else {
            XB_SPIN(xb_ld(&bar[XB_XGEN(b.x)]) == gen, bar);
            __builtin_amdgcn_fence(__ATOMIC_ACQUIRE, "agent");
            asm volatile("s_waitcnt vmcnt(0)" ::: "memory");
        }
    }
    __syncthreads();
}

constexpr int NWAVES = 8;
constexpr int LDS_BYTES = 147456;
constexpr int N_PHASES = 7;
static_assert(sa::Lay<4>::END <= LDS_BYTES && sa::Lay<2>::END <= LDS_BYTES && pg8::STAGE_BYTES <= LDS_BYTES, "LDS layouts fit the dynamic LDS array");

struct Args { const float* in[20]; float* out; unsigned char* ws; int ph_lo, ph_hi; };

__device__ __forceinline__ float wave_sum(float v) {
#pragma unroll
    for (int o = 1; o < 64; o <<= 1) v += __shfl_xor(v, o);
    return v;
}
__device__ __forceinline__ unsigned f2bf(float f) { unsigned u = __builtin_bit_cast(unsigned, f); return (u + 0x7fffu + ((u >> 16) & 1u)) >> 16; }
__device__ __forceinline__ unsigned pk2(float lo, float hi) { return f2bf(lo) | (f2bf(hi) << 16); }

__device__ __forceinline__ void transpose_item(const float* W, int K, int N, bf16_t* WT, bool permute, const float* gk, LAS float* scr, int item, int lane) {
    const int nblk = N / 32, kb = item / nblk, nb = item % nblk, k0 = 64 * kb, n0 = 32 * nb;
#pragma unroll 8
    for (int i = 0; i < 32; ++i) { const int kk = 2 * i + (lane >> 5); float w = W[(size_t)(k0 + kk) * N + n0 + (lane & 31)]; if (gk) w *= gk[k0 + kk]; scr[kk * 33 + (lane & 31)] = w; }
    asm volatile("s_waitcnt lgkmcnt(0)" ::: "memory");
    int prow0 = n0;
    if (permute) { const int gl = (n0 & 255) >> 5, wc = gl >> 1, bj = gl & 1; prow0 = (n0 & ~255) + (4 * bj + wc) * 32; }
    const int c = lane & 7;
#pragma unroll
    for (int j = 0; j < 4; ++j) { const int n = (lane >> 3) + 8 * j; const LAS float* s = scr + (8 * c) * 33 + n;
        u32x4 o; o.x = pk2(s[0 * 33], s[1 * 33]); o.y = pk2(s[2 * 33], s[3 * 33]); o.z = pk2(s[4 * 33], s[5 * 33]); o.w = pk2(s[6 * 33], s[7 * 33]);
        *(u32x4*)(WT + (size_t)(prow0 + n) * K + k0 + 8 * c) = o; }
    asm volatile("s_waitcnt lgkmcnt(0)" ::: "memory");
}

__global__ void __launch_bounds__(NWAVES * 64, 2) fwd_kernel(Args args) {
    extern __shared__ __attribute__((aligned(16))) unsigned char lds_raw[];
    LAS unsigned char* lds = (LAS unsigned char*)lds_raw;
    const int tid = threadIdx.x, lane = tid & 63, wid = __builtin_amdgcn_readfirstlane(tid >> 6);
    const int G = gridDim.x, bx = blockIdx.x;
    const int vcu = (G % 8 == 0) ? (bx % 8) * (G / 8) + bx / 8 : bx;
    const int r32 = lane & 31, hi = lane >> 5;
    unsigned char* ws = args.ws;
    const float* x = args.in[0];
    float* out = args.out;
    bf16_t* W0T = (bf16_t*)(ws + WS_W0T); bf16_t* WO0T = (bf16_t*)(ws + WS_WO0T); bf16_t* W1T = (bf16_t*)(ws + WS_W1T); bf16_t* WO1T = (bf16_t*)(ws + WS_WO1T);
    float* ROPE = (float*)(ws + WS_ROPE); float* SS = (float*)(ws + WS_SS);
    bf16_t* XN = (bf16_t*)(ws + WS_XN); bf16_t* MIX = (bf16_t*)(ws + WS_MIX); bf16_t* PROJ = (bf16_t*)(ws + WS_PROJ);
    const int lo = args.ph_lo, hi_ph = args.ph_hi;
#define IN(k) (lo <= (k) && (k) < hi_ph)
    volatile LAS unsigned* xb_st = (volatile LAS unsigned*)(lds + LDS_BYTES - 64);
    if (tid < 2) xb_st[tid] = 0u;
    __syncthreads();
    XcdBarrier xbar; xbar.bar = (unsigned*)ws; xbar.x = 0; xbar.st = xb_st;
    if (hi_ph - lo > 1) xbar = xcd_barrier_post((unsigned*)ws, xb_st);
#define SEAM(k) do { if (IN(k) && IN((k) + 1)) { xcd_barrier(xbar); } } while (0)

    if (IN(0)) {
        LAS float* scr = (LAS float*)(lds + wid * 16384);
        const int gw = vcu * NWAVES + wid, NGW = G * NWAVES;
        constexpr int I_0 = (DM / 64) * (N0 / 32), I_O = (DM / 64) * (DM / 32), I_1 = (DM / 64) * (N1 / 32);
        constexpr int NITEMS = I_0 + I_O + I_1 + I_O;
        for (int it = gw; it < NITEMS; it += NGW) {
            int r = it;
            if (r < I_0) { transpose_item(args.in[2], DM, N0, W0T, true, nullptr, scr, r, lane); continue; } r -= I_0;
            if (r < I_O) { transpose_item(args.in[3], DM, DM, WO0T, false, nullptr, scr, r, lane); continue; } r -= I_O;
            if (r < I_1) { transpose_item(args.in[11], DM, N1, W1T, true, args.in[10], scr, r, lane); continue; } r -= I_1;
            transpose_item(args.in[12], DM, DM, WO1T, false, nullptr, scr, r, lane);
        }
        for (int e = (vcu * NWAVES * 64) + tid; e < SEQ * 32; e += G * NWAVES * 64) {
            const int pos = e >> 5, i = e & 31;
            const float inv = 1.0f / powf(10000.0f, (float)(2 * i) / 64.0f);
            const float ang = (float)pos * inv;
            ROPE[e] = cosf(ang); ROPE[SEQ * 32 + e] = sinf(ang);
        }
        const float* gn = args.in[1];
        for (int mrow = gw; mrow < M_ROWS; mrow += NGW) {
            const f32x4* xr = (const f32x4*)(x + (size_t)mrow * DM) + lane;
            f32x4 v[4]; float s = 0.f;
#pragma unroll
            for (int j = 0; j < 4; ++j) { v[j] = xr[64 * j]; s += (v[j][0] * v[j][0] + v[j][1] * v[j][1]) + (v[j][2] * v[j][2] + v[j][3] * v[j][3]); }
            const float rstd = 1.0f / sqrtf(wave_sum(s) * (1.0f / DM) + EPS);
            unsigned long long* o8 = (unsigned long long*)(XN + (size_t)mrow * DM) + lane;
#pragma unroll
            for (int j = 0; j < 4; ++j) { const f32x4 g4 = *((const f32x4*)gn + lane + 64 * j);
                o8[64 * j] = (unsigned long long)pk2(v[j][0] * rstd * g4[0], v[j][1] * rstd * g4[1]) | ((unsigned long long)pk2(v[j][2] * rstd * g4[2], v[j][3] * rstd * g4[3]) << 32); }
        }
        __syncthreads();
    }
    SEAM(0);

    if (IN(1)) {
        pg8::Gemm g{XN, W0T, M_ROWS, N0, DM}; pg8::StaticOrder S; S.init(M_ROWS, N0, G, bx);
        pg8::EpiProj E{PROJ, N0, 0, args.in[4], args.in[5], args.in[7], args.in[8], ROPE, nullptr};
        pg8::gemm_phase<pg8::EpiProj, pg8::StaticOrder, true, true>(lds, g, S, E);
    }
    SEAM(1);

    if (IN(2)) {
        typedef sa::Lay<2> L;
        LAS char* al = (LAS char*)lds;
        LAS float* wsf = (LAS float*)(al + L::WSF) + wid * 64;
        LAS float* stg = (LAS float*)(al + L::STG + wid * L::STG_W);
        bool norefA, norefB;
        { float gqa = fabsf(args.in[4][lane]), gka = fabsf(args.in[5][lane]), gqb = fabsf(args.in[7][lane]), gkb = fabsf(args.in[8][lane]), bm = 0.f;
          for (int i_ = lane; i_ < 8 * 257; i_ += 64) bm = fmaxf(bm, fabsf(args.in[9][i_]));
#pragma unroll
          for (int o_ = 1; o_ < 64; o_ <<= 1) { gqa = fmaxf(gqa, __shfl_xor(gqa, o_)); gka = fmaxf(gka, __shfl_xor(gka, o_)); gqb = fmaxf(gqb, __shfl_xor(gqb, o_)); gkb = fmaxf(gkb, __shfl_xor(gkb, o_)); bm = fmaxf(bm, __shfl_xor(bm, o_)); }
          norefA = __builtin_amdgcn_readfirstlane((64.0f * C2 * gqa * gka <= 60.0f) ? 1 : 0) != 0;
          norefB = __builtin_amdgcn_readfirstlane((64.0f * C2 * gqb * gkb + 2.0f * LOG2E * bm <= 60.0f) ? 1 : 0) != 0; }
        auto gate_ld = [&](u32x4 (&gt)[4], size_t qrow0, int gcol) {
#pragma unroll
            for (int i = 0; i < 4; ++i) { const int row = i * 8 + (lane >> 3), c8 = lane & 7; gt[i] = *(const u32x4*)(PROJ + (qrow0 + row) * N0 + gcol + c8 * 8); } };
        auto epi_ab = [&](const f32x16 (&o)[2], float scl, size_t qrow0, const u32x4 (&gtv)[4], int mcol) {
            if (hi == 0) wsf[32 + r32] = scl;
#pragma unroll
            for (int g = 0; g < 4; ++g) { const f32x4 s4 = *(const LAS f32x4*)(wsf + 32 + 8 * g + 4 * hi);
#pragma unroll
                for (int d0 = 0; d0 < 2; ++d0)
#pragma unroll
                    for (int j = 0; j < 4; ++j) stg[(8 * g + 4 * hi + j) * 64 + d0 * 32 + r32] = o[d0][4 * g + j] * s4[j]; }
#pragma unroll
            for (int i = 0; i < 4; ++i) { const int row = i * 8 + (lane >> 3), c8 = lane & 7;
                const f32x4 a = *(const LAS f32x4*)(stg + row * 64 + c8 * 8), bb = *(const LAS f32x4*)(stg + row * 64 + c8 * 8 + 4);
                const u32x4 gt = gtv[i];
                u32x4 w; w.x = sa::cvtpk(a[0] * sa::bf_lo(gt.x), a[1] * sa::bf_hi(gt.x)); w.y = sa::cvtpk(a[2] * sa::bf_lo(gt.y), a[3] * sa::bf_hi(gt.y));
                w.z = sa::cvtpk(bb[0] * sa::bf_lo(gt.z), bb[1] * sa::bf_hi(gt.z)); w.w = sa::cvtpk(bb[2] * sa::bf_lo(gt.w), bb[3] * sa::bf_hi(gt.w));
                *(u32x4*)(MIX + (qrow0 + row) * DM + mcol + c8 * 8) = w; }
        };
        bf16x8 qr[4];
        struct GA { int c, b, kvh, hq, t_lo; size_t qrow0; const bf16_t *Qw, *Kh, *Vh; };
        auto geom_a = [&](int id) { GA g; g.c = id & 127; const int bk = id >> 7; g.b = bk >> 1; g.kvh = bk & 1; g.hq = g.kvh * 4 + (wid >> 1);
            g.qrow0 = (size_t)g.b * SEQ + g.c * 64 + (wid & 1) * 32; g.t_lo = g.c >= 2 ? g.c - 2 : 0;
            g.Qw = PROJ + g.qrow0 * N0 + C_AQ + g.hq * 64; g.Kh = PROJ + (size_t)g.b * SEQ * N0 + C_AK + g.kvh * 64; g.Vh = PROJ + (size_t)g.b * SEQ * N0 + C_AV + g.kvh * 64; return g; };
        if (norefA && vcu < BATCH * 2 * 128) { const GA g = geom_a(vcu); sa::pp_prefetch<2>(al, g.Qw, N0, g.Kh + (size_t)g.t_lo * 64 * N0, N0, g.Vh + (size_t)g.t_lo * 64 * N0, N0, g.c + 1 - g.t_lo, qr); }
        for (int id = vcu; id < BATCH * 2 * 128; id += G) {
            const GA g = geom_a(id);
            f32x16 o[2]; float m, l;
            u32x4 gtv[4]; gate_ld(gtv, g.qrow0, C_AG + g.hq * 64);
            const float sink = args.in[6][g.hq];
            if (norefA) {
                sa::stream_pp<2, true, 0>(al, g.Kh + (size_t)g.t_lo * 64 * N0, N0, g.Vh + (size_t)g.t_lo * 64 * N0, N0, g.c + 1 - g.t_lo, 0, g.c - g.t_lo, 0, 0, qr, o, l, m);
                if (id + G < BATCH * 2 * 128) { const GA n = geom_a(id + G);
                    sa::pp_prefetch<2>(al, n.Qw, N0, n.Kh + (size_t)n.t_lo * 64 * N0, N0, n.Vh + (size_t)n.t_lo * 64 * N0, N0, n.c + 1 - n.t_lo, qr); }
            } else sa::stream<2, 0>(al, g.Qw, N0, g.Kh, N0, g.Vh, N0, g.t_lo, g.c + 1, g.t_lo, g.c, 0, 0, o, m, l);
            float lt = sa::swap_sum(l);
            const float s2 = sink * LOG2E, mf = fmaxf(m, s2), e1 = __builtin_amdgcn_exp2f(m - mf);
            lt = lt * e1 + __builtin_amdgcn_exp2f(s2 - mf);
            epi_ab(o, e1 / lt, g.qrow0, gtv, g.hq * 64);
        }
        struct GB { int b, h, c0, cw, t_lo, w_lo; size_t qrow0; const bf16_t *Qw, *Kh, *Vh; };
        auto geom_b = [&](int id) { GB g; const int cg4 = id & 31, bh = id >> 5; g.b = bh >> 3; g.h = bh & 7; g.c0 = cg4 * 4; g.cw = g.c0 + (wid >> 1);
            g.qrow0 = (size_t)g.b * SEQ + g.cw * 64 + (wid & 1) * 32; g.t_lo = g.c0 >= 8 ? g.c0 - 8 : 0; g.w_lo = g.cw >= 8 ? g.cw - 8 : 0;
            g.Qw = PROJ + g.qrow0 * N0 + C_BQ + g.h * 64; g.Kh = PROJ + (size_t)g.b * SEQ * N0 + C_BK + g.h * 64; g.Vh = PROJ + (size_t)g.b * SEQ * N0 + C_BV + g.h * 64; return g; };
        LAS float* tabw = (LAS float*)(al + L::TAB);
        auto fill_tab = [&](int h) { if (tid < 320) tabw[tid] = (args.in[9][h * 257 + (tid < 256 ? tid : 256)] - args.in[9][h * 257 + 256]) * LOG2E; };
        if (norefB && vcu < BATCH * 8 * 32) { const GB g = geom_b(vcu); fill_tab(g.h);
            sa::pp_prefetch<2>(al, g.Qw, N0, g.Kh + (size_t)g.t_lo * 64 * N0, N0, g.Vh + (size_t)g.t_lo * 64 * N0, N0, g.c0 + 4 - g.t_lo, qr); }
        for (int id = vcu; id < BATCH * 8 * 32; id += G) {
            const GB g = geom_b(id);
            f32x16 o[2]; float m, l;
            u32x4 gtv[4]; gate_ld(gtv, g.qrow0, C_BG + g.h * 64);
            if (norefB) {
                sa::stream_pp<2, true, 1>(al, g.Kh + (size_t)g.t_lo * 64 * N0, N0, g.Vh + (size_t)g.t_lo * 64 * N0, N0, g.c0 + 4 - g.t_lo, g.w_lo - g.t_lo, g.cw - g.t_lo, g.cw - g.t_lo, (wid & 1) * 32, qr, o, l, m);
                if (id + G < BATCH * 8 * 32) { const GB n = geom_b(id + G); if (n.h != g.h) fill_tab(n.h);
                    sa::pp_prefetch<2>(al, n.Qw, N0, n.Kh + (size_t)n.t_lo * 64 * N0, N0, n.Vh + (size_t)n.t_lo * 64 * N0, N0, n.c0 + 4 - n.t_lo, qr); }
            } else { fill_tab(g.h); sa::stream<2, 1>(al, g.Qw, N0, g.Kh, N0, g.Vh, N0, g.t_lo, g.c0 + 4, g.w_lo, g.cw, g.cw, (wid & 1) * 32, o, m, l); }
            epi_ab(o, 1.0f / sa::swap_sum(l), g.qrow0, gtv, 512 + g.h * 64);
        }
        asm volatile("s_waitcnt vmcnt(0) lgkmcnt(0)" ::: "memory");
        __syncthreads();
    }
    SEAM(2);

    if (IN(3)) {
        pg8::Gemm g{MIX, WO0T, M_ROWS, DM, DM}; pg8::StaticOrder S; S.init(M_ROWS, DM, G, bx);
        pg8::EpiRes E{x, nullptr, nullptr, XN, SS};
        pg8::gemm_phase<pg8::EpiRes, pg8::StaticOrder, true, true>(lds, g, S, E);
    }
    SEAM(3);

    if (IN(4)) {
        pg8::Gemm g{XN, W1T, M_ROWS, N1, DM}; pg8::StaticOrder S; S.init(M_ROWS, N1, G, bx);
        pg8::EpiProj E{PROJ, N1, 1, args.in[13], args.in[14], nullptr, nullptr, ROPE, SS};
        pg8::gemm_phase<pg8::EpiProj, pg8::StaticOrder, true, true>(lds, g, S, E);
    }
    SEAM(4);

    if (IN(5)) {
        typedef sa::Lay<4> L;
        LAS char* al = (LAS char*)lds;
        float lam;
        { const float a = args.in[15][lane] * args.in[16][lane], bq = args.in[17][lane] * args.in[18][lane];
          lam = __expf(wave_sum(a)) - __expf(wave_sum(bq)) + LAMBDA_INIT; }
        const float* subg = args.in[19];
        bool noref;
        { float gq = fabsf(args.in[13][lane]), gk = fabsf(args.in[14][lane]);
#pragma unroll
          for (int o_ = 1; o_ < 64; o_ <<= 1) { gq = fmaxf(gq, __shfl_xor(gq, o_)); gk = fmaxf(gk, __shfl_xor(gk, o_)); }
          noref = __builtin_amdgcn_readfirstlane((64.0f * C2 * gq * gk <= 60.0f) ? 1 : 0) != 0; }
        const bf16_t* Q1 = PROJ; const bf16_t* K1 = PROJ + (size_t)M_ROWS * 1024; const bf16_t* V1 = PROJ + (size_t)M_ROWS * 2048; const bf16_t* G1 = PROJ + (size_t)M_ROWS * 3072;
        struct GC { int b, h, qb, cw, T; size_t qrow0; const bf16_t *Qp, *Kp, *Vh; };
        auto geom_c = [&](int id, int pass) { GC g; const int i = id >> 8, v = id & 255, bh = v >> 3, s = v & 7; g.b = bh >> 3; g.h = bh & 7;
            g.qb = (i == 0) ? s : (i == 1) ? 15 - s : (i == 2) ? 16 + s : 31 - s; g.cw = g.qb * 4 + (wid >> 1); g.T = g.qb * 4 + 4;
            g.qrow0 = (size_t)g.b * SEQ + g.qb * 256 + wid * 32; const int vh = 2 * g.h + 1 - pass;
            g.Qp = Q1 + ((size_t)(g.b * 16 + vh) * SEQ + g.qb * 256 + wid * 32) * 64; g.Kp = K1 + (size_t)(g.b * 16 + vh) * SEQ * 64; g.Vh = V1 + (size_t)(g.b * 8 + g.h) * SEQ * 128; return g; };
        bf16x8 qr[4];
        if (vcu < BATCH * 8 * 32) { const GC g = geom_c(vcu, 0); sa::pp_prefetch<4>(al, g.Qp, 64, g.Kp, 64, g.Vh, 128, g.T, qr); }
        for (int id = vcu; id < BATCH * 8 * 32; id += G) {
            const GC g0 = geom_c(id, 0);
            const int h = g0.h; const size_t qrow0 = g0.qrow0;
            f32x16 o[4]; float l, mref;
#pragma clang loop unroll(disable)
            for (int pass = 0; pass < 2; ++pass) {
                const GC g = geom_c(id, pass);
                if (noref) sa::stream_pp<4, true, 0>(al, g.Kp, 64, g.Vh, 128, g.T, 0, g.cw, 0, 0, qr, o, l, mref);
                else sa::stream_pp<4, false, 0>(al, g.Kp, 64, g.Vh, 128, g.T, 0, g.cw, 0, 0, qr, o, l, mref);
                if (pass == 0) { const GC n = geom_c(id, 1); sa::pp_prefetch<4>(al, n.Qp, 64, n.Kp, 64, n.Vh, 128, n.T, qr); }
                else if (id + G < BATCH * 8 * 32) { const GC n = geom_c(id + G, 0); sa::pp_prefetch<4>(al, n.Qp, 64, n.Kp, 64, n.Vh, 128, n.T, qr); }
                if (pass == 0) {
                    const float scl = 1.0f / sa::swap_sum(l);
                    int le = lane; asm volatile("" : "+v"(le));
                    const int r32e = le & 31, hie = le >> 5;
                    LAS float* wsfe = (LAS float*)(al + L::WSF) + wid * 64;
                    LAS unsigned* parke = (LAS unsigned*)(al + L::STG + wid * L::STG_W) + le;
                    if (hie == 0) wsfe[32 + r32e] = scl;
#pragma unroll
                    for (int g = 0; g < 4; ++g) { const f32x4 s4 = *(const LAS f32x4*)(wsfe + 32 + 8 * g + 4 * hie);
#pragma unroll
                        for (int d0 = 0; d0 < 4; ++d0) { parke[(d0 * 8 + 2 * g) * 64] = sa::cvtpk(o[d0][4 * g] * s4[0], o[d0][4 * g + 1] * s4[1]); parke[(d0 * 8 + 2 * g + 1) * 64] = sa::cvtpk(o[d0][4 * g + 2] * s4[2], o[d0][4 * g + 3] * s4[3]); } }
                }
            }
            int le = lane; asm volatile("" : "+v"(le));
            const int r32e = le & 31, hie = le >> 5;
            LAS float* wsfe = (LAS float*)(al + L::WSF) + wid * 64;
            LAS float* stge = (LAS float*)(al + L::STG + wid * L::STG_W);
            const LAS unsigned* parke = (const LAS unsigned*)stge + le;
            unsigned o2p[4][8];
#pragma unroll
            for (int d0 = 0; d0 < 4; ++d0)
#pragma unroll
                for (int k = 0; k < 8; ++k) o2p[d0][k] = parke[(d0 * 8 + k) * 64];
            asm volatile("s_waitcnt lgkmcnt(0)" ::: "memory");
            const float scl = 1.0f / sa::swap_sum(l);
            if (hie == 0) wsfe[32 + r32e] = scl;
#pragma unroll
            for (int rd = 0; rd < 2; ++rd) {
#pragma unroll
                for (int gg = 0; gg < 2; ++gg) { const int g = 2 * rd + gg; const f32x4 s4 = *(const LAS f32x4*)(wsfe + 32 + 8 * g + 4 * hie);
#pragma unroll
                    for (int d0 = 0; d0 < 4; ++d0)
#pragma unroll
                        for (int j = 0; j < 4; ++j) { const unsigned w2 = o2p[d0][2 * g + (j >> 1)]; const float o2 = (j & 1) ? sa::bf_hi(w2) : sa::bf_lo(w2);
                            stge[(8 * gg + 4 * hie + j) * 128 + d0 * 32 + r32e] = o[d0][4 * g + j] * s4[j] - lam * o2; } }
#pragma unroll
                for (int ii = 0; ii < 4; ++ii) { const int row = ii * 4 + (le >> 4), c8 = le & 15;
                    const f32x4 a = *(const LAS f32x4*)(stge + row * 128 + c8 * 8), bb = *(const LAS f32x4*)(stge + row * 128 + c8 * 8 + 4);
                    float q = (a[0] * a[0] + a[1] * a[1]) + (a[2] * a[2] + a[3] * a[3]) + (bb[0] * bb[0] + bb[1] * bb[1]) + (bb[2] * bb[2] + bb[3] * bb[3]);
                    q += __shfl_xor(q, 1); q += __shfl_xor(q, 2); q += __shfl_xor(q, 4); q += __shfl_xor(q, 8);
                    const float rn = (1.0f - LAMBDA_INIT) / sqrtf(q * (1.0f / 128.0f) + EPS);
                    const f32x4 g0 = *(const f32x4*)(subg + c8 * 8), g1 = *(const f32x4*)(subg + c8 * 8 + 4);
                    const size_t grow = qrow0 + 16 * rd + row;
                    const u32x4 gt = *(const u32x4*)(G1 + grow * 1024 + h * 128 + c8 * 8);
                    u32x4 w; w.x = sa::cvtpk(a[0] * rn * g0[0] * sa::bf_lo(gt.x), a[1] * rn * g0[1] * sa::bf_hi(gt.x)); w.y = sa::cvtpk(a[2] * rn * g0[2] * sa::bf_lo(gt.y), a[3] * rn * g0[3] * sa::bf_hi(gt.y));
                    w.z = sa::cvtpk(bb[0] * rn * g1[0] * sa::bf_lo(gt.z), bb[1] * rn * g1[1] * sa::bf_hi(gt.z)); w.w = sa::cvtpk(bb[2] * rn * g1[2] * sa::bf_lo(gt.w), bb[3] * rn * g1[3] * sa::bf_hi(gt.w));
                    *(u32x4*)(MIX + grow * DM + h * 128 + c8 * 8) = w; }
            }
        }
        asm volatile("s_waitcnt vmcnt(0) lgkmcnt(0)" ::: "memory");
        __syncthreads();
    }
    SEAM(5);

    if (IN(6)) {
        pg8::Gemm g{MIX, WO1T, M_ROWS, DM, DM}; pg8::StaticOrder S; S.init(M_ROWS, DM, G, bx);
        pg8::EpiRes E{nullptr, XN, out, nullptr, nullptr};
        pg8::gemm_phase<pg8::EpiRes, pg8::StaticOrder, true, true>(lds, g, S, E);
    }
#undef IN
#undef SEAM
}

extern "C" void kernel_launch(void* const* d_in, const int* in_sizes, int n_in, void* d_out, int out_size, void* d_ws, size_t ws_size, hipStream_t stream) {
    static int grid = 0;
    if (grid == 0) {
        if (n_in != 20 || in_sizes[0] != M_ROWS * DM || out_size != M_ROWS * DM || ws_size < WS_END) {
            fprintf(stderr, "kernel_launch: unexpected problem (n_in %d, in0 %d, out %d, ws %zu; need ws >= %zu); nothing launched\n", n_in, n_in > 0 ? in_sizes[0] : -1, out_size, ws_size, (size_t)WS_END);
            grid = -1; return; }
        int dev = 0, cus = 0, per_cu = 0;
        if (hipGetDevice(&dev) != hipSuccess || hipDeviceGetAttribute(&cus, hipDeviceAttributeMultiprocessorCount, dev) != hipSuccess) { fprintf(stderr, "kernel_launch: device query failed\n"); grid = -1; return; }
        if (hipFuncSetAttribute((const void*)fwd_kernel, hipFuncAttributeMaxDynamicSharedMemorySize, LDS_BYTES) != hipSuccess) { fprintf(stderr, "kernel_launch: hipFuncSetAttribute failed\n"); grid = -1; return; }
        if (hipOccupancyMaxActiveBlocksPerMultiprocessor(&per_cu, (const void*)fwd_kernel, NWAVES * 64, LDS_BYTES) != hipSuccess || per_cu < 1) {
            fprintf(stderr, "kernel_launch: the occupancy query admits %d workgroups of this kernel per CU; nothing launched\n", per_cu); (void)hipGetLastError(); grid = -1; return; }
        grid = cus * (per_cu < 1 ? per_cu : 1);
    }
    if (grid < 0) return;
    if (hipMemsetAsync(d_ws, 0, XCD_BAR_WORDS * 4, stream) != hipSuccess) { fprintf(stderr, "kernel_launch: hipMemsetAsync of the barrier words failed\n"); return; }
    Args a{};
    for (int i = 0; i < 20; ++i) a.in[i] = (const float*)d_in[i];
    a.out = (float*)d_out; a.ws = (unsigned char*)d_ws;
#if MK_N_LAUNCHES == 1
    a.ph_lo = 0; a.ph_hi = N_PHASES;
    void* kargs[] = {&a};
    hipError_t e = hipLaunchCooperativeKernel((const void*)fwd_kernel, dim3(grid), dim3(NWAVES * 64), kargs, LDS_BYTES, stream);
    if (e != hipSuccess) fprintf(stderr, "kernel_launch: cooperative launch failed: %s (grid %d)\n", hipGetErrorString(e), grid);
#else
    for (int p = 0; p < N_PHASES; ++p) {
        a.ph_lo = p; a.ph_hi = p + 1;
        for (int rep = 1; rep < (p == PROBE_PHASE ? PROBE_REPS : 1); ++rep) hipLaunchKernelGGL(fwd_kernel, dim3(grid), dim3(NWAVES * 64), LDS_BYTES, stream, a);
        hipLaunchKernelGGL(fwd_kernel, dim3(grid), dim3(NWAVES * 64), LDS_BYTES, stream, a);
        const hipError_t le = hipPeekAtLastError();
        if (le != hipSuccess) { fprintf(stderr, "kernel_launch: launch %d failed: %s\n", p, hipGetErrorName(le)); break; }
    }
#endif
}
```

```cpp
#include <hip/hip_runtime.h>
#include <cstdio>
#include <cstdint>

#ifndef MK_N_LAUNCHES
#define MK_N_LAUNCHES 1
#endif

#ifndef PROBE_PHASE
#define PROBE_PHASE -1
#endif
#ifndef PROBE_REPS
#define PROBE_REPS 2
#endif

#define LAS __attribute__((address_space(3)))
typedef unsigned short bf16_t;
typedef short bf16x8 __attribute__((ext_vector_type(8)));
typedef short s16x4 __attribute__((ext_vector_type(4)));
typedef float f32x4 __attribute__((ext_vector_type(4)));
typedef float f32x16 __attribute__((ext_vector_type(16)));
typedef unsigned u32x4 __attribute__((ext_vector_type(4)));
typedef unsigned u32x2 __attribute__((ext_vector_type(2)));

constexpr int BATCH = 4, SEQ = 8192, DM = 1024, M_ROWS = BATCH * SEQ;
constexpr int N0 = 3328, N1 = 4096;
constexpr float EPS = 1e-6f;
constexpr float LOG2E = 1.4426950408889634f;
constexpr float C2 = 0.125f * LOG2E;
constexpr float LAMBDA_INIT = 0.35550906759096927f;
constexpr int C_AQ = 0, C_AK = 512, C_AV = 640, C_AG = 768, C_BQ = 1280, C_BK = 1792, C_BV = 2304, C_BG = 2816;
constexpr int C_CQ = 0, C_CK = 1024, C_CV = 2048, C_CG = 3072;

constexpr size_t MiB = 1u << 20;
constexpr size_t WS_W0T = 1 * MiB;
constexpr size_t WS_WO0T = 8 * MiB;
constexpr size_t WS_W1T = 10 * MiB;
constexpr size_t WS_WO1T = 18 * MiB;
constexpr size_t WS_ROPE = 20 * MiB;
constexpr size_t WS_SS = 22 * MiB;
constexpr size_t WS_XN = 32 * MiB;
constexpr size_t WS_MIX = 96 * MiB;
constexpr size_t WS_PROJ = 160 * MiB;
constexpr size_t WS_END = 416 * MiB;

namespace pg8 {
constexpr int BM = 256, BK = 64, HALF = 128, HTB = HALF * BK * 2, STAGE_BYTES = 8 * HTB, NXCD = 8, WGM = 4;
__host__ __device__ __forceinline__ int lds_byte(int r, int c) { const int st = (r >> 4) * 2 + (c >> 5), rr = r & 15, cc = c & 31, ob = rr * 64 + cc * 2; return st * 1024 + (ob ^ (((ob >> 9) & 1) << 5)); }
__host__ __device__ __forceinline__ void stage_rc(int b, int& R, int& C) { const int st = b / 1024, sb = b % 1024, swz = sb ^ (((sb >> 9) & 1) << 5); R = (st >> 1) * 16 + swz / 64; C = (st & 1) * 32 + (swz % 64) / 2; }
__host__ __device__ __forceinline__ int perm32(int rho) { const int n = rho >> 4, i = rho & 15; return 8 * (i >> 2) + 4 * n + (i & 3); }

struct Unit { int pm, pn; };
struct Gemm { const bf16_t* A; const bf16_t* Bt; int M, N, K; };

struct StaticOrder {
    int nM, nN, nwg, G, c;
    __host__ __device__ void init(int M, int N, int G_, int c_) { nM = M / BM; nN = N / BM; nwg = nM * nN; G = G_; c = c_; }
    __host__ __device__ bool next(int i, Unit& u) const {
        const long L = (long)i * G + c; if (L >= nwg) return false;
        int wgid = (int)L; { const int q = nwg / NXCD, r = nwg % NXCD, xcd = wgid % NXCD, off = wgid / NXCD; wgid = (xcd < r ? xcd * (q + 1) : r * (q + 1) + (xcd - r) * q) + off; }
        const int nig = WGM * nN, gid = wgid / nig, fm = gid * WGM, gsz = (nM - fm) < WGM ? (nM - fm) : WGM;
        u.pm = fm + ((wgid % nig) % gsz); u.pn = (wgid % nig) / gsz; return true;
    }
    __device__ __forceinline__ void a_ready(const Unit&) const {}
    __device__ __forceinline__ void done(const Unit&) const {}
};

__device__ __forceinline__ unsigned cvt_pk_bf16(float lo, float hi) { unsigned r; asm volatile("s_nop 0\n\tv_cvt_pk_bf16_f32 %0, %1, %2" : "=v"(r) : "v"(lo), "v"(hi)); return r; }

struct EpiProj {
    static constexpr bool PERM = true, AFTER_DRAIN = false;
    bf16_t* O; int ldc; int layer;
    const float* g_q; const float* g_k; const float* g_q2; const float* g_k2;
    const float* rope;
    const float* ss;
    __device__ __forceinline__ void operator()(const f32x4 (&acc)[2][2][4][2], const Unit& u, int wr, int wc, int fr, int fq) const {
        const int gh = 4 * u.pn + wc;
        const float* gp = nullptr; bool rope_on = false, silu_on = false; float sc = 1.f;
        if (layer == 0) {
            if (gh < 8) { gp = g_q; rope_on = true; sc = C2; } else if (gh < 10) { gp = g_k; rope_on = true; } else if (gh < 12) {} else if (gh < 20) { silu_on = true; }
            else if (gh < 28) { gp = g_q2; sc = C2; } else if (gh < 36) { gp = g_k2; } else if (gh < 44) {} else { silu_on = true; }
        } else {
            if (gh < 16) { gp = g_q; rope_on = true; sc = C2; } else if (gh < 32) { gp = g_k; rope_on = true; } else if (gh < 48) {} else { silu_on = true; }
        }
        f32x4 gv[2][2];
#pragma unroll
        for (int bj = 0; bj < 2; ++bj)
#pragma unroll
            for (int n = 0; n < 2; ++n) gv[bj][n] = gp ? *(const f32x4*)(gp + 32 * bj + 8 * fq + 4 * n) : (f32x4){1.f, 1.f, 1.f, 1.f};
        bf16_t* dbuf = O; int NH = 1, hidx = 0, RP = ldc, coff = u.pn * BM + 64 * wc;
        if (layer == 1) {
            if (gh < 16) { dbuf = O; NH = 16; hidx = gh; RP = 64; coff = 0; }
            else if (gh < 32) { dbuf = O + (size_t)M_ROWS * 1024; NH = 16; hidx = gh - 16; RP = 64; coff = 0; }
            else if (gh < 48) { dbuf = O + (size_t)M_ROWS * 2048; NH = 8; hidx = (gh - 32) >> 1; RP = 128; coff = ((gh - 32) & 1) * 64; }
            else { dbuf = O + (size_t)M_ROWS * 3072; NH = 1; hidx = 0; RP = 1024; coff = (gh - 48) * 64; }
        }
        const int colo = coff + 8 * fq;
        const int row0 = u.pm * BM + wr * 64 + fr;
        float rs[8];
        if (ss) {
            f32x4 p4[8];
#pragma unroll
            for (int g = 0; g < 8; ++g) p4[g] = *(const f32x4*)(ss + (size_t)(row0 + (g >> 2) * HALF + (g & 3) * 16) * 16 + 4 * fq);
#pragma unroll
            for (int g = 0; g < 8; ++g) { float q = (p4[g][0] + p4[g][1]) + (p4[g][2] + p4[g][3]); q += __shfl_xor(q, 16); q += __shfl_xor(q, 32); rs[g] = __builtin_amdgcn_rsqf(q * (1.0f / 1024.0f) + EPS); }
        } else {
#pragma unroll
            for (int g = 0; g < 8; ++g) rs[g] = 1.f;
        }
        f32x4 rc[3][2][2];
        const float* rtab = rope + 8 * fq;
#define EP_ROPE_LD(g) do { const int pos_ = (row0 + ((g) >> 2) * HALF + ((g) & 3) * 16) & (SEQ - 1); _Pragma("unroll") for (int n = 0; n < 2; ++n) { \
            rc[(g) % 3][n][0] = *(const f32x4*)(rtab + (size_t)pos_ * 32 + 4 * n); rc[(g) % 3][n][1] = *(const f32x4*)(rtab + (size_t)SEQ * 32 + (size_t)pos_ * 32 + 4 * n); } } while (0)
        if (rope_on) { EP_ROPE_LD(0); EP_ROPE_LD(1); }
#pragma unroll
        for (int g = 0; g < 8; ++g) {
            const int ai = g >> 2, m = g & 3;
            const int row = row0 + ai * HALF + m * 16;
            const size_t drow = (size_t)((row >> 13) * NH + hidx) * SEQ + (row & (SEQ - 1));
            if (rope_on && g + 2 < 8) EP_ROPE_LD(g + 2);
            f32x4 v[2][2];
#pragma unroll
            for (int bj = 0; bj < 2; ++bj)
#pragma unroll
                for (int n = 0; n < 2; ++n) v[bj][n] = acc[ai][bj][m][n] * rs[g];
            if (gp) {
                float q = 0.f;
#pragma unroll
                for (int bj = 0; bj < 2; ++bj)
#pragma unroll
                    for (int n = 0; n < 2; ++n) { const f32x4 x = v[bj][n]; q += (x[0] * x[0] + x[1] * x[1]) + (x[2] * x[2] + x[3] * x[3]); }
                q += __shfl_xor(q, 16); q += __shfl_xor(q, 32);
                const float rn = __builtin_amdgcn_rsqf(q * (1.0f / 64.0f) + EPS);
#pragma unroll
                for (int bj = 0; bj < 2; ++bj)
#pragma unroll
                    for (int n = 0; n < 2; ++n) v[bj][n] = v[bj][n] * rn * gv[bj][n];
            }
            if (rope_on) {
#pragma unroll
                for (int n = 0; n < 2; ++n) {
                    const f32x4 c = rc[g % 3][n][0], sn = rc[g % 3][n][1];
                    const f32x4 x1 = v[0][n], x2 = v[1][n];
                    v[0][n] = x1 * c - x2 * sn; v[1][n] = x2 * c + x1 * sn;
                }
            }
#pragma unroll
            for (int bj = 0; bj < 2; ++bj) {
                f32x4 a = v[bj][0] * sc, b = v[bj][1] * sc;
                if (silu_on) {
#pragma unroll
                    for (int j = 0; j < 4; ++j) { a[j] = a[j] * __builtin_amdgcn_rcpf(1.0f + __builtin_amdgcn_exp2f(-LOG2E * a[j])); b[j] = b[j] * __builtin_amdgcn_rcpf(1.0f + __builtin_amdgcn_exp2f(-LOG2E * b[j])); }
                }
                u32x4 w; w.x = cvt_pk_bf16(a[0], a[1]); w.y = cvt_pk_bf16(a[2], a[3]); w.z = cvt_pk_bf16(b[0], b[1]); w.w = cvt_pk_bf16(b[2], b[3]);
                *(u32x4*)(dbuf + drow * RP + colo + 32 * bj) = w;
            }
        }
#undef EP_ROPE_LD
    }
};
struct EpiRes {
    static constexpr bool PERM = true, AFTER_DRAIN = false;
    const float* base; const bf16_t* base16; float* out; bf16_t* xb; float* ss;
    __device__ __forceinline__ void operator()(const f32x4 (&acc)[2][2][4][2], const Unit& u, int wr, int wc, int fr, int fq) const {
#pragma unroll
        for (int ai = 0; ai < 2; ++ai)
#pragma unroll
            for (int m = 0; m < 4; ++m) {
                const int row = u.pm * BM + ai * HALF + wr * 64 + m * 16 + fr;
                float q = 0.f;
#pragma unroll
                for (int bj = 0; bj < 2; ++bj) {
                    const size_t off = (size_t)row * DM + u.pn * BM + bj * HALF + wc * 32 + 8 * fq;
                    f32x4 b0, b1;
                    if (base16) { const u32x4 w = *(const u32x4*)(base16 + off);
                        b0 = (f32x4){__uint_as_float(w.x << 16), __uint_as_float(w.x & 0xffff0000u), __uint_as_float(w.y << 16), __uint_as_float(w.y & 0xffff0000u)};
                        b1 = (f32x4){__uint_as_float(w.z << 16), __uint_as_float(w.z & 0xffff0000u), __uint_as_float(w.w << 16), __uint_as_float(w.w & 0xffff0000u)}; }
                    else { b0 = *(const f32x4*)(base + off); b1 = *(const f32x4*)(base + off + 4); }
                    const f32x4 a = acc[ai][bj][m][0] + b0, b = acc[ai][bj][m][1] + b1;
                    if (out) { *(f32x4*)(out + off) = a; *(f32x4*)(out + off + 4) = b; }
                    q += (a[0] * a[0] + a[1] * a[1]) + (a[2] * a[2] + a[3] * a[3]) + (b[0] * b[0] + b[1] * b[1]) + (b[2] * b[2] + b[3] * b[3]);
                    if (xb) { u32x4 w; w.x = cvt_pk_bf16(a[0], a[1]); w.y = cvt_pk_bf16(a[2], a[3]); w.z = cvt_pk_bf16(b[0], b[1]); w.w = cvt_pk_bf16(b[2], b[3]); *(u32x4*)(xb + off) = w; }
                }
                if (ss) { q += __shfl_xor(q, 16); q += __shfl_xor(q, 32); if (fq == 0) ss[(size_t)row * 16 + u.pn * 4 + wc] = q; }
            }
    }
};

template <class Epi, class Sched, bool ALIGN_EPI = false, bool SP2 = false>
__device__ __forceinline__ void gemm_phase(LAS unsigned char* lds, const Gemm g, const Sched& S, const Epi& E) {
    const int tid = threadIdx.x, wid = __builtin_amdgcn_readfirstlane(tid >> 6), lane = tid & 63, wr = wid >> 2, wc = wid & 3, fr = lane & 15, fq = lane >> 4;
    const int K = g.K, nt = K / BK;
    unsigned voffA[2], voffB[2];
#pragma unroll
    for (int i = 0; i < 2; ++i) { int R, C; stage_rc(tid * 16 + i * 8192, R, C); const int Rb = Epi::PERM ? ((R & ~31) + perm32(R & 31)) : R;
        voffA[i] = (unsigned)(R * K + C) * 2u; voffB[i] = (unsigned)(Rb * K + C) * 2u; }
    const size_t kstep = (size_t)(BK * 2);
    const size_t hstep = (size_t)HALF * K * 2;
    const size_t tstep = 2 * hstep;
    const unsigned ldsw = (unsigned)wid * 1024u;
    const int aoff = lds_byte(wr * 64 + fr, fq * 8), boff = lds_byte(wc * 32 + fr, fq * 8);
#define PG8_SA(b, h) (((b) * 2 + (h)) * HTB)
#define PG8_SB(b, h) ((4 + (b) * 2 + (h)) * HTB)
#define PG8_STAGE(bufoff, gbase, voff) do { _Pragma("unroll") for (int _i = 0; _i < 2; ++_i) \
        __builtin_amdgcn_global_load_lds((const unsigned*)((const char*)(gbase) + (voff)[_i]), (LAS unsigned*)(lds + (bufoff) + ldsw + _i * 8192), 16, 0, 0); } while (0)
#define PG8_LDA(dst, b, h) do { _Pragma("unroll") for (int m = 0; m < 4; ++m) _Pragma("unroll") for (int k = 0; k < 2; ++k) dst[m][k] = *(const LAS bf16x8*)(lds + PG8_SA(b, h) + aoff + m * 2048 + k * 1024); } while (0)
#define PG8_LDB(dst, b, h) do { _Pragma("unroll") for (int n = 0; n < 2; ++n) _Pragma("unroll") for (int k = 0; k < 2; ++k) dst[n][k] = *(const LAS bf16x8*)(lds + PG8_SB(b, h) + boff + n * 2048 + k * 1024); } while (0)
#define PG8_MMA(ai, bj, At, Bt) do { __builtin_amdgcn_s_setprio(1); _Pragma("unroll") for (int m = 0; m < 4; ++m) _Pragma("unroll") for (int n = 0; n < 2; ++n) _Pragma("unroll") for (int k = 0; k < 2; ++k) \
        acc[ai][bj][m][n] = __builtin_amdgcn_mfma_f32_16x16x32_bf16(Bt[n][k], At[m][k], acc[ai][bj][m][n], 0, 0, 0); __builtin_amdgcn_s_setprio(0); } while (0)
#define PG8_WAIT_V(n) asm volatile("s_waitcnt vmcnt(" #n ")" ::: "memory")
#define PG8_WAIT_L(n) asm volatile("s_waitcnt lgkmcnt(" #n ")" ::: "memory")
#define PG8_BAR __builtin_amdgcn_s_barrier()
#define PG8_SCHED __builtin_amdgcn_sched_barrier(0)
    Unit cur, nxt; int ui = 0;
    if (!S.next(0, cur)) return;
    f32x4 acc[2][2][4][2];
#pragma unroll
    for (int a = 0; a < 2; ++a)
#pragma unroll
        for (int b = 0; b < 2; ++b)
#pragma unroll
            for (int m = 0; m < 4; ++m)
#pragma unroll
                for (int n = 0; n < 2; ++n) acc[a][b][m][n] = (f32x4){0.f, 0.f, 0.f, 0.f};
    bf16x8 At[4][2], B0[2][2], B1[2][2];
    const char* cA = (const char*)g.A + (size_t)cur.pm * tstep; const char* cB = (const char*)g.Bt + (size_t)cur.pn * tstep;
    S.a_ready(cur);
    if constexpr (SP2) {
        PG8_STAGE(PG8_SB(0, 0), cB, voffB); PG8_STAGE(PG8_SB(0, 1), cB + hstep, voffB); PG8_STAGE(PG8_SA(0, 0), cA, voffA); PG8_STAGE(PG8_SA(0, 1), cA + hstep, voffA);
        if (wr == 1) PG8_BAR;
        PG8_WAIT_V(2); PG8_BAR;
        PG8_STAGE(PG8_SB(1, 0), cB + kstep, voffB); PG8_STAGE(PG8_SA(1, 0), cA + kstep, voffA); PG8_STAGE(PG8_SB(1, 1), cB + hstep + kstep, voffB);
        PG8_WAIT_V(6); PG8_BAR;
    } else {
        PG8_STAGE(PG8_SB(0, 0), cB, voffB); PG8_STAGE(PG8_SA(0, 0), cA, voffA); PG8_STAGE(PG8_SB(0, 1), cB + hstep, voffB); PG8_STAGE(PG8_SA(0, 1), cA + hstep, voffA);
        if (wr == 1) PG8_BAR;
        PG8_WAIT_V(4); PG8_BAR;
        PG8_STAGE(PG8_SB(1, 0), cB + kstep, voffB); PG8_STAGE(PG8_SA(1, 0), cA + kstep, voffA); PG8_STAGE(PG8_SB(1, 1), cB + hstep + kstep, voffB);
        PG8_WAIT_V(6); PG8_BAR;
    }
    for (;;) {
        const bool has_next = S.next(ui + 1, nxt);
        const char* nA = has_next ? (const char*)g.A + (size_t)nxt.pm * tstep : cA; const char* nB = has_next ? (const char*)g.Bt + (size_t)nxt.pn * tstep : cB;
        for (int t = 0; t < nt; t += 2) {
            const bool last = (t == nt - 2);
            const char* a1 = cA + (size_t)(t + 1) * kstep;
            const char* a2 = last ? nA : cA + (size_t)(t + 2) * kstep; const char* b2 = last ? nB : cB + (size_t)(t + 2) * kstep;
            const char* a3 = a2 + kstep; const char* b3 = b2 + kstep;
            if (last && has_next) S.a_ready(nxt);
            if constexpr (SP2) {
            PG8_LDB(B0, 0, 0); PG8_LDB(B1, 0, 1); PG8_SCHED; PG8_LDA(At, 0, 0); PG8_STAGE(PG8_SA(1, 1), a1 + hstep, voffA);
            PG8_WAIT_V(8); PG8_WAIT_L(0); PG8_BAR; PG8_MMA(0, 0, At, B0); PG8_MMA(0, 1, At, B1); PG8_BAR; PG8_SCHED;
            PG8_LDA(At, 0, 1); PG8_STAGE(PG8_SB(0, 0), b2, voffB); PG8_STAGE(PG8_SB(0, 1), b2 + hstep, voffB); PG8_STAGE(PG8_SA(0, 0), a2, voffA);
            PG8_WAIT_V(8); PG8_WAIT_L(0); PG8_BAR; PG8_MMA(1, 0, At, B0); PG8_MMA(1, 1, At, B1); PG8_BAR; PG8_SCHED;
            PG8_LDB(B0, 1, 0); PG8_LDB(B1, 1, 1); PG8_SCHED; PG8_LDA(At, 1, 0); PG8_STAGE(PG8_SA(0, 1), a2 + hstep, voffA);
            PG8_WAIT_V(8); PG8_WAIT_L(0); PG8_BAR; PG8_MMA(0, 0, At, B0); PG8_MMA(0, 1, At, B1); PG8_BAR; PG8_SCHED;
            PG8_LDA(At, 1, 1); PG8_STAGE(PG8_SB(1, 0), b3, voffB); PG8_STAGE(PG8_SB(1, 1), b3 + hstep, voffB); PG8_STAGE(PG8_SA(1, 0), a3, voffA);
            PG8_WAIT_V(8); PG8_WAIT_L(0); PG8_BAR; PG8_MMA(1, 0, At, B0); PG8_MMA(1, 1, At, B1); PG8_BAR; PG8_SCHED;
            } else {
            PG8_LDB(B0, 0, 0); PG8_SCHED; PG8_LDA(At, 0, 0); PG8_STAGE(PG8_SA(1, 1), a1 + hstep, voffA);
            PG8_WAIT_L(8); PG8_BAR; PG8_WAIT_L(0); PG8_MMA(0, 0, At, B0); PG8_BAR; PG8_SCHED;
            PG8_LDB(B1, 0, 1); PG8_STAGE(PG8_SB(0, 0), b2, voffB);
            PG8_BAR; PG8_WAIT_L(0); PG8_MMA(0, 1, At, B1); PG8_BAR;
            PG8_LDA(At, 0, 1); PG8_STAGE(PG8_SA(0, 0), a2, voffA);
            PG8_BAR; PG8_WAIT_L(0); PG8_MMA(1, 0, At, B0); PG8_BAR; PG8_SCHED;
            PG8_STAGE(PG8_SB(0, 1), b2 + hstep, voffB);
            PG8_WAIT_V(6); PG8_BAR; PG8_MMA(1, 1, At, B1); PG8_BAR;
            PG8_LDB(B0, 1, 0); PG8_SCHED; PG8_LDA(At, 1, 0); PG8_STAGE(PG8_SA(0, 1), a2 + hstep, voffA);
            PG8_WAIT_L(8); PG8_BAR; PG8_WAIT_L(0); PG8_MMA(0, 0, At, B0); PG8_BAR; PG8_SCHED;
            PG8_LDB(B1, 1, 1); PG8_STAGE(PG8_SB(1, 0), b3, voffB);
            PG8_BAR; PG8_WAIT_L(0); PG8_MMA(0, 1, At, B1); PG8_BAR;
            PG8_LDA(At, 1, 1); PG8_STAGE(PG8_SA(1, 0), a3, voffA);
            PG8_BAR; PG8_WAIT_L(0); PG8_MMA(1, 0, At, B0); PG8_BAR; PG8_SCHED;
            PG8_STAGE(PG8_SB(1, 1), b3 + hstep, voffB);
            PG8_WAIT_V(6); PG8_BAR; PG8_MMA(1, 1, At, B1); PG8_BAR;
            }
        }
        if constexpr (ALIGN_EPI) { if (wr == 0) PG8_BAR; }
        if constexpr (!Epi::AFTER_DRAIN) { E(acc, cur, wr, wc, fr, fq); S.done(cur); }
        if (!has_next) break;
#pragma unroll
        for (int a = 0; a < 2; ++a)
#pragma unroll
            for (int b = 0; b < 2; ++b)
#pragma unroll
                for (int m = 0; m < 4; ++m)
#pragma unroll
                    for (int n = 0; n < 2; ++n) acc[a][b][m][n] = (f32x4){0.f, 0.f, 0.f, 0.f};
        cur = nxt; cA = nA; cB = nB; ++ui;
        if constexpr (ALIGN_EPI) { if (wr == 1) PG8_BAR; }
    }
    PG8_WAIT_V(0);
    if constexpr (!ALIGN_EPI) { if (wr == 0) PG8_BAR; }
    PG8_BAR;
#undef PG8_SA
#undef PG8_SB
#undef PG8_STAGE
#undef PG8_LDA
#undef PG8_LDB
#undef PG8_MMA
#undef PG8_WAIT_V
#undef PG8_WAIT_L
#undef PG8_BAR
#undef PG8_SCHED
}
}

namespace sa {
typedef LAS const char* lds_cptr;
typedef short v4i16_t __attribute__((ext_vector_type(4)));
__device__ __forceinline__ unsigned cvtpk(float lo, float hi) { unsigned r; asm("s_nop 0\n\tv_cvt_pk_bf16_f32 %0, %1, %2" : "=v"(r) : "v"(lo), "v"(hi)); return r; }
__device__ __forceinline__ void glds16(const void* g, unsigned lds_base) {
    unsigned sv; asm volatile("s_mov_b32 %0, m0\n\ts_mov_b32 m0, %2\n\ts_nop 0\n\tglobal_load_lds_dwordx4 %1, off\n\ts_mov_b32 m0, %0" : "=&s"(sv) : "v"(g), "s"(lds_base) : "memory"); }
__device__ __forceinline__ s16x4 vtr(lds_cptr p) { return __builtin_bit_cast(s16x4, __builtin_amdgcn_ds_read_tr16_b64_v4i16((LAS v4i16_t*)p)); }
__device__ __forceinline__ void glds16s(unsigned voff, const void* sbase, unsigned lds_base) {
    unsigned sv; asm volatile("s_mov_b32 %0, m0\n\ts_mov_b32 m0, %3\n\ts_nop 4\n\tglobal_load_lds_dwordx4 %1, %2\n\ts_mov_b32 m0, %0" : "=&s"(sv) : "v"(voff), "s"(sbase), "s"(lds_base) : "memory"); }
__device__ __forceinline__ float max3f(float a, float b, float c) { float r; asm("v_max3_f32 %0, %1, %2, %3" : "=v"(r) : "v"(a), "v"(b), "v"(c)); return r; }
__device__ __forceinline__ unsigned cvtpk_c(float lo, float hi) { typedef float f2 __attribute__((ext_vector_type(2))); typedef __bf16 b2 __attribute__((ext_vector_type(2))); f2 v = {lo, hi}; b2 b = __builtin_convertvector(v, b2); return __builtin_bit_cast(unsigned, b); }
#define SA_MFMA(a, b, c) __builtin_amdgcn_mfma_f32_32x32x16_bf16(a, b, c, 0, 0, 0)
#define SA_WAIT_BAR() asm volatile("s_waitcnt vmcnt(0) lgkmcnt(0)\n\ts_barrier" ::: "memory")
__device__ __forceinline__ float swap_sum(float v) { auto rr = __builtin_amdgcn_permlane32_swap(__float_as_uint(v), __float_as_uint(v), false, false); return __uint_as_float(rr[0]) + __uint_as_float(rr[1]); }
__device__ __forceinline__ float swap_max(float v) { auto rr = __builtin_amdgcn_permlane32_swap(__float_as_uint(v), __float_as_uint(v), false, false); return fmaxf(__uint_as_float(rr[0]), __uint_as_float(rr[1])); }
__device__ __forceinline__ float bf_lo(unsigned w) { return __uint_as_float(w << 16); }
__device__ __forceinline__ float bf_hi(unsigned w) { return __uint_as_float(w & 0xffff0000u); }

template <int NDB> struct Lay {
    static constexpr int NSLOT = 3, SLOT_K = 8192, SLOT_V = NDB * 4096, SLOT = SLOT_K + SLOT_V;
    static constexpr int WSF = NSLOT * SLOT, TAB = WSF + 2048, STG = TAB + 1280, STG_W = 8192, END = STG + 8 * STG_W;
};
constexpr float THR = 8.0f;

template <int NDB, int MODE>
__device__ __forceinline__ void stream(LAS char* lds, const bf16_t* Qw, int pq, const bf16_t* Kh, int pk, const bf16_t* Vh, int pv, int t_lo, int t_hi, int w_lo, int w_hi,
                                       int cw, int qi0, f32x16 (&o)[NDB], float& m, float& l) {
    typedef Lay<NDB> L;
    const int tid = threadIdx.x, lane = tid & 63, r32 = lane & 31, hi = lane >> 5; const int wid = __builtin_amdgcn_readfirstlane(tid >> 6);
    const unsigned lds0 = (unsigned)(size_t)lds;
    LAS float* wsf = (LAS float*)(lds + L::WSF) + wid * 64;
    const LAS float* tab = (const LAS float*)(lds + L::TAB);
    const bf16_t* ksrc = Kh + (size_t)lane * pk + wid * 8;
    auto issue = [&](int t, int slot) {
        glds16(ksrc + (size_t)t * 64 * pk, (unsigned)__builtin_amdgcn_readfirstlane(lds0 + slot * L::SLOT + wid * 1024));
#pragma unroll
        for (int j = 0; j < NDB / 2; ++j) { const int pc = wid + 8 * j;
            const bf16_t* vsrc = Vh + (size_t)(t * 64 + 16 * (pc & 3) + (lane >> 2)) * pv + (pc >> 2) * 32 + (lane & 3) * 8;
            glds16(vsrc, (unsigned)__builtin_amdgcn_readfirstlane(lds0 + slot * L::SLOT + L::SLOT_K + pc * 1024)); }
    };
    bf16x8 qr[4];
#pragma unroll
    for (int d0 = 0; d0 < 4; ++d0) qr[d0] = *(const bf16x8*)(Qw + (size_t)r32 * pq + d0 * 16 + hi * 8);
    issue(t_lo, 0);
    if (t_lo + 1 < t_hi) issue(t_lo + 1, 1);
#pragma unroll
    for (int d0 = 0; d0 < NDB; ++d0) o[d0] = f32x16{};
    m = 0.f; l = 0.f;
    f32x16 negm = f32x16{};
    if (t_lo + 1 < t_hi) { if (NDB == 4) asm volatile("s_waitcnt vmcnt(3) lgkmcnt(0)\n\ts_barrier" ::: "memory"); else asm volatile("s_waitcnt vmcnt(2) lgkmcnt(0)\n\ts_barrier" ::: "memory"); }
    else SA_WAIT_BAR();
    int cur = 0;
    for (int t = t_lo; t < t_hi; ++t) {
        const int nx2 = cur == 0 ? 2 : cur - 1;
        const bool more = t + 2 < t_hi;
        if (more) issue(t + 2, nx2);
        if (t >= w_lo && t <= w_hi) {
            const lds_cptr kb = (lds_cptr)lds + cur * L::SLOT + hi * 1024 + r32 * 16;
            f32x16 p0, p1;
#pragma unroll
            for (int d0 = 0; d0 < 4; ++d0) {
                const bf16x8 b0 = *(const LAS bf16x8*)(kb + d0 * 2048), b1 = *(const LAS bf16x8*)(kb + d0 * 2048 + 512);
                if (d0 == 0) { p0 = SA_MFMA(b0, qr[0], negm); p1 = SA_MFMA(b1, qr[0], negm); }
                else { p0 = SA_MFMA(b0, qr[d0], p0); p1 = SA_MFMA(b1, qr[d0], p1); }
            }
            if (MODE == 1) {
                const int dist = cw - t;
                if (dist >= 3) { const float cb = tab[256];
#pragma unroll
                    for (int r = 0; r < 16; ++r) { p0[r] += cb; p1[r] += cb; } }
                else { const int ib = dist * 64 + qi0 + r32 + 128 - 4 * hi;
#pragma unroll
                    for (int r = 0; r < 16; ++r) { const int k = (r & 3) + 8 * (r >> 2); int i0 = ib - k, i1 = ib - k - 32; i0 = i0 > 256 ? 256 : i0; i1 = i1 > 256 ? 256 : i1; p0[r] += tab[i0]; p1[r] += tab[i1]; } }
            }
            float rm = fmaxf(p0[0], p1[0]);
#pragma unroll
            for (int r = 1; r < 16; ++r) rm = fmaxf(rm, fmaxf(p0[r], p1[r]));
            rm = swap_max(rm);
            const bool first = (t == w_lo);
            if (first || __any(rm > THR)) {
                const float dl = first ? rm : fmaxf(rm, 0.f), al = first ? 1.f : __builtin_amdgcn_exp2f(-dl); l *= al; m += dl;
#pragma unroll
                for (int r = 0; r < 16; ++r) { p0[r] -= dl; p1[r] -= dl; negm[r] = -m; }
                if (hi == 0) wsf[r32] = al;
#pragma unroll
                for (int g = 0; g < 4; ++g) { const f32x4 a4 = *(const LAS f32x4*)(wsf + 8 * g + 4 * hi);
#pragma unroll
                    for (int d0 = 0; d0 < NDB; ++d0)
#pragma unroll
                        for (int j = 0; j < 4; ++j) o[d0][4 * g + j] *= a4[j]; }
            }
            float sum = 0.f;
#pragma unroll
            for (int r = 0; r < 16; ++r) { p0[r] = __builtin_amdgcn_exp2f(p0[r]); p1[r] = __builtin_amdgcn_exp2f(p1[r]); sum += p0[r] + p1[r]; }
            l += sum;
            u32x4 pw[4];
#pragma unroll
            for (int j = 0; j < 4; ++j) { pw[0][j] = cvtpk(p0[2 * j], p0[2 * j + 1]); pw[1][j] = cvtpk(p0[8 + 2 * j], p0[9 + 2 * j]); pw[2][j] = cvtpk(p1[2 * j], p1[2 * j + 1]); pw[3][j] = cvtpk(p1[8 + 2 * j], p1[9 + 2 * j]); }
            const lds_cptr vp = (lds_cptr)lds + cur * L::SLOT + L::SLOT_K + ((lane >> 4) & 1) * 32 + (lane & 3) * 8 + (4 * hi + ((lane & 15) >> 2)) * 64;
#pragma unroll
            for (int d0 = 0; d0 < NDB; ++d0) {
#pragma unroll
                for (int ks = 0; ks < 4; ++ks) {
                    const s16x4 lo = vtr(vp + d0 * 4096 + ks * 1024), hh = vtr(vp + d0 * 4096 + ks * 1024 + 512);
                    const bf16x8 vf = (bf16x8){lo[0], lo[1], lo[2], lo[3], hh[0], hh[1], hh[2], hh[3]};
                    o[d0] = SA_MFMA(__builtin_bit_cast(bf16x8, pw[ks]), vf, o[d0]);
                }
            }
        }
        if (more) { if (NDB == 4) asm volatile("s_waitcnt vmcnt(3) lgkmcnt(0)\n\ts_barrier" ::: "memory"); else asm volatile("s_waitcnt vmcnt(2) lgkmcnt(0)\n\ts_barrier" ::: "memory"); }
        else SA_WAIT_BAR();
        cur = cur == 2 ? 0 : cur + 1;
    }
}

template <int NDB> struct PPIssue {
    typedef Lay<NDB> L;
    unsigned lds0, kvoff, vvoff[NDB / 2]; int wid, pk, pv, T; const bf16_t* Kh; const bf16_t* Vh;
    __device__ __forceinline__ void init(LAS char* lds, const bf16_t* Kh_, int pk_, const bf16_t* Vh_, int pv_, int T_) {
        const int tid = threadIdx.x, lane = tid & 63; wid = __builtin_amdgcn_readfirstlane(tid >> 6);
        lds0 = (unsigned)(size_t)lds; Kh = Kh_; Vh = Vh_; pk = pk_; pv = pv_; T = T_;
        kvoff = (unsigned)(((8 * wid + (lane >> 3)) * pk + (((lane & 7) ^ ((4 * wid + (lane >> 4)) & 7)) * 8)) * 2);
#pragma unroll
        for (int j = 0; j < NDB / 2; ++j) { const int pc = wid + 8 * j; vvoff[j] = (unsigned)(((16 * (pc & 3) + (lane >> 2)) * pv + (pc >> 2) * 32 + (lane & 3) * 8) * 2); }
    }
    __device__ __forceinline__ void issue(int gt, int slot) const {
        const int kt = gt < T ? gt : T - 1, vt = gt >= 1 ? gt - 1 : 0;
        glds16s(kvoff, Kh + (size_t)kt * 64 * pk, (unsigned)__builtin_amdgcn_readfirstlane(lds0 + slot * L::SLOT + wid * 1024));
#pragma unroll
        for (int j = 0; j < NDB / 2; ++j) { const int pc = wid + 8 * j;
            glds16s(vvoff[j], Vh + (size_t)vt * 64 * pv, (unsigned)__builtin_amdgcn_readfirstlane(lds0 + slot * L::SLOT + L::SLOT_K + pc * 1024)); }
    }
};
template <int NDB>
__device__ __forceinline__ void pp_prefetch(LAS char* lds, const bf16_t* Qw, int pq, const bf16_t* Kh, int pk, const bf16_t* Vh, int pv, int T, bf16x8 (&qr)[4]) {
    const int lane = threadIdx.x & 63, r32 = lane & 31, hi = lane >> 5;
    PPIssue<NDB> I; I.init(lds, Kh, pk, Vh, pv, T);
#pragma unroll
    for (int d0 = 0; d0 < 4; ++d0) qr[d0] = *(const bf16x8*)(Qw + (size_t)r32 * pq + d0 * 16 + hi * 8);
    I.issue(0, 0); I.issue(1, 1);
}
template <int NDB, bool NOREF, int MODE>
__device__ __forceinline__ void stream_pp(LAS char* lds, const bf16_t* Kh, int pk, const bf16_t* Vh, int pv, int T, int w_lo, int w_hi, int cwr, int qi0, const bf16x8 (&qr)[4],
                                          f32x16 (&o)[NDB], float& l, float& m) {
    typedef Lay<NDB> L;
    static_assert(NDB == 4 || NDB == 2, "a group is 1 K + NDB/2 V pieces per wave: the counted waits below leave exactly one group in flight");
    constexpr int NF = 8 + 4 * NDB;
    const LAS float* tab = (const LAS float*)(lds + L::TAB);
    const int tid = threadIdx.x, lane = tid & 63, r32 = lane & 31, hi = lane >> 5; const int wid = __builtin_amdgcn_readfirstlane(tid >> 6);
    const int role = wid >> 2;
    LAS float* wsf = (LAS float*)(lds + L::WSF) + wid * 64;
    PPIssue<NDB> I; I.init(lds, Kh, pk, Vh, pv, T);
    auto issue = [&](int gt, int slot) { I.issue(gt, slot); };
#pragma unroll
    for (int d0 = 0; d0 < NDB; ++d0) o[d0] = f32x16{};
    m = 0.f; l = 0.f;
    f32x16 p0 = f32x16{}, p1 = f32x16{};
    u32x4 pw[4] = {};
    constexpr int PP_D = 6; bf16x8 fr[PP_D];
#define PP_WAITN() do { if (NDB == 4) asm volatile("s_waitcnt vmcnt(3) lgkmcnt(0)\n\ts_barrier" ::: "memory"); else asm volatile("s_waitcnt vmcnt(2) lgkmcnt(0)\n\ts_barrier" ::: "memory"); } while (0)
    PP_WAITN();
    __builtin_amdgcn_sched_barrier(0);
    int slot_m = 0;
    int slot_i = 2;
    const int kx0 = r32 * 128 + ((hi ^ ((r32 >> 1) & 7)) * 16);
    const lds_cptr vp0 = (lds_cptr)lds + L::SLOT_K + ((lane >> 4) & 1) * 32 + (lane & 3) * 8 + (4 * hi + ((lane & 15) >> 2)) * 64;
#define PP_ISSUE(t) do { if ((t) + 2 <= T) { issue((t) + 2, slot_i); slot_i = slot_i == 2 ? 0 : slot_i + 1; } } while (0)
#define PP_BAR_EVEN() do { __builtin_amdgcn_sched_barrier(0); } while (0)
#define PP_BAR_ODD(t) do { __builtin_amdgcn_sched_barrier(0); if ((t) + 2 <= T) PP_WAITN(); else SA_WAIT_BAR(); \
        __builtin_amdgcn_sched_barrier(0); slot_m = slot_m == 2 ? 0 : slot_m + 1; } while (0)
#define PP_SB() __builtin_amdgcn_sched_barrier(0)
#define PP_FRD(i) do { if ((i) < 8) { const int d0_ = (i) >> 1; fr[(i) % PP_D] = *(const LAS bf16x8*)((lds_cptr)lds + slot_m * L::SLOT + (kx0 ^ (d0_ * 32)) + ((i) & 1) * 4096); } \
        else { const lds_cptr vp_ = vp0 + slot_m * L::SLOT + (((i) - 8) >> 2) * 4096 + (((i) - 8) & 3) * 1024; const s16x4 lo_ = vtr(vp_), hh_ = vtr(vp_ + 512); \
               fr[(i) % PP_D] = (bf16x8){lo_[0], lo_[1], lo_[2], lo_[3], hh_[0], hh_[1], hh_[2], hh_[3]}; } } while (0)
#define PP_FMA(i) do { if ((i) < 8) { if ((i) & 1) p1 = SA_MFMA(fr[(i) % PP_D], qr[(i) >> 1], p1); else p0 = SA_MFMA(fr[(i) % PP_D], qr[(i) >> 1], p0); } \
        else o[((i) - 8) >> 2] = SA_MFMA(__builtin_bit_cast(bf16x8, pw[((i) - 8) & 3]), fr[(i) % PP_D], o[((i) - 8) >> 2]); } while (0)
#define PP_PIPE(lo, hi) do { \
        _Pragma("unroll") for (int i_ = (lo); i_ < (lo) + PP_D && i_ < (hi); ++i_) PP_FRD(i_); \
        if ((lo) < 8) { if (NOREF) { p0 = f32x16{}; p1 = f32x16{}; } else { _Pragma("unroll") for (int r = 0; r < 16; ++r) { p0[r] = -m; p1[r] = -m; } } } \
        PP_SB(); \
        _Pragma("unroll") for (int i_ = (lo); i_ < (hi); ++i_) { PP_FMA(i_); if (i_ + PP_D < (hi)) PP_FRD(i_ + PP_D); PP_SB(); } \
        if ((lo) < 8) asm volatile("" : "+v"(p0), "+v"(p1)); } while (0)
#define PP_QK() PP_PIPE(0, 8)
#define PP_PV() PP_PIPE(8, NF)
#define PP_QKPV() PP_PIPE(0, NF)
#define PP_SOFT(first, ts) do { \
        if (MODE == 1) { const int dist_ = cwr - (ts); \
            if (dist_ < 3) {     \
                const LAS float* fb_ = tab + (dist_ * 64 + qi0 + r32 + 128 - 4 * hi - 59);     \
                _Pragma("unroll") for (int r = 0; r < 16; ++r) { const int k_ = (r & 3) + 8 * (r >> 2); p0[r] += fb_[59 - k_]; p1[r] += fb_[27 - k_]; } } } \
        if (!NOREF) { \
        asm volatile("s_nop 15\n\ts_nop 3" : "+v"(p0), "+v"(p1));     \
        float rm = max3f(p0[0], p1[0], p0[1]), rm2 = max3f(p1[1], p0[2], p1[2]); \
        _Pragma("unroll") for (int r = 3; r < 15; r += 2) { rm = max3f(rm, p0[r], p1[r]); rm2 = max3f(rm2, p0[r + 1], p1[r + 1]); } \
        rm = max3f(rm, p0[15], p1[15]); rm = fmaxf(rm, rm2); \
        rm = swap_max(rm); \
        if ((first) || __any(rm > THR)) { \
            const float dl = (first) ? rm : fmaxf(rm, 0.f), al = (first) ? 1.f : __builtin_amdgcn_exp2f(-dl); l *= al; m += dl; \
            _Pragma("unroll") for (int r = 0; r < 16; ++r) { p0[r] -= dl; p1[r] -= dl; } \
            if (hi == 0) wsf[r32] = al; \
            _Pragma("unroll") for (int gq = 0; gq < 4; ++gq) { const f32x4 a4 = *(const LAS f32x4*)(wsf + 8 * gq + 4 * hi); \
                _Pragma("unroll") for (int d0 = 0; d0 < NDB; ++d0) _Pragma("unroll") for (int j = 0; j < 4; ++j) o[d0][4 * gq + j] *= a4[j]; } } } \
        float sum = 0.f; \
        _Pragma("unroll") for (int r = 0; r < 16; ++r) { p0[r] = __builtin_amdgcn_exp2f(p0[r]); p1[r] = __builtin_amdgcn_exp2f(p1[r]); sum += p0[r] + p1[r]; } \
        l += sum; \
        _Pragma("unroll") for (int j = 0; j < 4; ++j) { pw[0][j] = cvtpk_c(p0[2 * j], p0[2 * j + 1]); pw[1][j] = cvtpk_c(p0[8 + 2 * j], p0[9 + 2 * j]); pw[2][j] = cvtpk_c(p1[2 * j], p1[2 * j + 1]); pw[3][j] = cvtpk_c(p1[8 + 2 * j], p1[9 + 2 * j]); } \
        asm volatile("" : "+v"(pw[0]), "+v"(pw[1]), "+v"(pw[2]), "+v"(pw[3]), "+v"(l));     \
        } while (0)
    if (role == 0) {
#pragma clang loop unroll(disable)
        for (int t = 0; t < w_lo; ++t) { PP_ISSUE(t); PP_BAR_ODD(t); }
        { const int t = w_lo; PP_QK(); PP_BAR_EVEN(); PP_ISSUE(t); PP_SOFT(true, t); PP_BAR_ODD(t); }
#pragma clang loop unroll(disable)
        for (int t = w_lo + 1; t <= w_hi; ++t) {
            PP_QKPV(); PP_BAR_EVEN(); PP_ISSUE(t); PP_SOFT(false, t); PP_BAR_ODD(t);
        }
        { const int t = w_hi + 1; PP_PV(); PP_BAR_EVEN(); PP_ISSUE(t); PP_BAR_ODD(t); }
#pragma clang loop unroll(disable)
        for (int t = w_hi + 2; t <= T; ++t) { PP_ISSUE(t); PP_BAR_EVEN(); PP_BAR_ODD(t); }
    } else {
#pragma clang loop unroll(disable)
        for (int t = 0; t < w_lo; ++t) { PP_ISSUE(t); PP_BAR_ODD(t); }
        { const int t = w_lo; PP_ISSUE(t); PP_BAR_EVEN(); PP_QK(); PP_BAR_ODD(t); }
#pragma clang loop unroll(disable)
        for (int t = w_lo + 1; t <= w_hi; ++t) {
            PP_ISSUE(t); PP_SOFT(t - 1 == w_lo, t - 1); PP_BAR_EVEN(); PP_QKPV(); PP_BAR_ODD(t);
        }
        { const int t = w_hi + 1; PP_ISSUE(t); PP_SOFT(t - 1 == w_lo, t - 1); PP_BAR_EVEN(); PP_PV(); PP_BAR_ODD(t); }
#pragma clang loop unroll(disable)
        for (int t = w_hi + 2; t <= T; ++t) { PP_ISSUE(t); PP_BAR_EVEN(); PP_BAR_ODD(t); }
    }
#undef PP_ISSUE
#undef PP_WAITN
#undef PP_BAR_EVEN
#undef PP_BAR_ODD
#undef PP_QK
#undef PP_SB
#undef PP_QKPV
#undef PP_FRD
#undef PP_FMA
#undef PP_PIPE
#undef PP_PV
#undef PP_SOFT
}
}

#define XB_TMO      128
#define XB_XCNT(j)  (256  + 64 * (j))
#define XB_XSUB(j)  (1280 + 64 * (j))
#define XB_XGEN(j)  (2304 + 64 * (j))
#define XB_TOP      3328
#define XB_TOPGEN   3392
#define XCD_BAR_WORDS 3456
#define XB_SPIN_CAP (1u << 18)
__device__ __forceinline__ unsigned xb_ld(unsigned* p)              { return __hip_atomic_load(p, __ATOMIC_RELAXED, __HIP_MEMORY_SCOPE_AGENT); }
__device__ __forceinline__ unsigned xb_add(unsigned* p, unsigned v) { return __hip_atomic_fetch_add(p, v, __ATOMIC_RELAXED, __HIP_MEMORY_SCOPE_AGENT); }
__device__ __forceinline__ unsigned xb_xcc_id() { return (unsigned)__builtin_amdgcn_s_getreg((3 << 11) | 20) & 0xFu; }
#define XB_SPIN(cond, bar) do { unsigned _sp = 0; while (cond) { __builtin_amdgcn_s_sleep(1); \
    if ((++_sp & 255u) == 0u) { if (xb_ld(&(bar)[XB_TMO])) break; if (_sp > XB_SPIN_CAP) { atomicAdd(&(bar)[XB_TMO], 1u); break; } } } } while (0)
struct XcdBarrier { unsigned* bar; unsigned x; volatile LAS unsigned* st; };
__device__ __forceinline__ XcdBarrier xcd_barrier_post(unsigned* bar, volatile LAS unsigned* st) {
    XcdBarrier b; b.bar = bar; b.x = xb_xcc_id(); b.st = st;
    if (threadIdx.x == 0) (void)xb_add(&bar[XB_XCNT(b.x)], 1u);
    return b;
}
__device__ __forceinline__ void xcd_barrier_complete(unsigned* bar, unsigned x, unsigned& nloc, unsigned& nx) {
    const unsigned G = gridDim.x * gridDim.y * gridDim.z;
    unsigned sum, cnt, mine, sp = 0u;
    for (;;) {
        sum = 0u; cnt = 0u; mine = 0u;
#pragma unroll
        for (unsigned j = 0; j < 16; ++j) { const unsigned c = xb_ld(&bar[XB_XCNT(j)]); sum += c; cnt += (c > 0u) ? 1u : 0u; mine = (j == x) ? c : mine; }
        if (sum == G) break;
        __builtin_amdgcn_s_sleep(1);
        if ((++sp & 255u) == 0u) { if (xb_ld(&bar[XB_TMO])) break; if (sp > XB_SPIN_CAP) { atomicAdd(&bar[XB_TMO], 1u); break; } }
    }
    nloc = mine > 0u ? mine : 1u; nx = cnt > 0u ? cnt : 1u;
}
__device__ __forceinline__ void xcd_barrier(const XcdBarrier& b) {
    asm volatile("s_waitcnt vmcnt(0)" ::: "memory");
    __syncthreads();
    if (threadIdx.x == 0) {
        unsigned* bar = b.bar;
        __builtin_amdgcn_s_waitcnt(0);
        unsigned nloc = b.st[0], nx = b.st[1];
        if (nloc == 0u) { xcd_barrier_complete(bar, b.x, nloc, nx); b.st[0] = nloc; b.st[1] = nx; }
        const unsigned old = xb_add(&bar[XB_XSUB(b.x)], 1u);
        const unsigned gen = old / nloc;
        if (old + 1u == (gen + 1u) * nloc) {
            __builtin_amdgcn_fence(__ATOMIC_RELEASE, "agent");
            asm volatile("s_waitcnt vmcnt(0)" ::: "memory");
            const unsigned og = xb_add(&bar[XB_TOP], 1u);
            const unsigned tg = og / nx;
            if (og + 1u == (tg + 1u) * nx) xb_add(&bar[XB_TOPGEN], 1u);
            else XB_SPIN(xb_ld(&bar[XB_TOPGEN]) == tg, bar);
            __builtin_amdgcn_fence(__ATOMIC_ACQUIRE, "agent");
            xb_add(&bar[XB_XGEN(b.x)], 1u);
            asm volatile("s_waitcnt vmcnt(0)" ::: "memory");
        } else {
            XB_SPIN(xb_ld(&bar[XB_XGEN(b.x)]) == gen, bar);
            __builtin_amdgcn_fence(__ATOMIC_ACQUIRE, "agent");
            asm volatile("s_waitcnt vmcnt(0)" ::: "memory");
        }
    }
    __syncthreads();
}

constexpr int NWAVES = 8;
constexpr int LDS_BYTES = 147456;
constexpr int N_PHASES = 7;
static_assert(sa::Lay<4>::END <= LDS_BYTES && sa::Lay<2>::END <= LDS_BYTES && pg8::STAGE_BYTES <= LDS_BYTES, "LDS layouts fit the dynamic LDS array");

struct Args { const float* in[20]; float* out; unsigned char* ws; int ph_lo, ph_hi; };

__device__ __forceinline__ float wave_sum(float v) {
#pragma unroll
    for (int o = 1; o < 64; o <<= 1) v += __shfl_xor(v, o);
    return v;
}
__device__ __forceinline__ unsigned f2bf(float f) { unsigned u = __builtin_bit_cast(unsigned, f); return (u + 0x7fffu + ((u >> 16) & 1u)) >> 16; }
__device__ __forceinline__ unsigned pk2(float lo, float hi) { return f2bf(lo) | (f2bf(hi) << 16); }

__device__ __forceinline__ void transpose_item(const float* W, int K, int N, bf16_t* WT, bool permute, const float* gk, LAS float* scr, int item, int lane) {
    const int nblk = N / 32, kb = item / nblk, nb = item % nblk, k0 = 64 * kb, n0 = 32 * nb;
    f32x4 wv[8];
#pragma unroll
    for (int i = 0; i < 8; ++i) wv[i] = *(const f32x4*)(W + (size_t)(k0 + 8 * i + (lane >> 3)) * N + n0 + 4 * (lane & 7));
#pragma unroll
    for (int i = 0; i < 8; ++i) { const int kk = 8 * i + (lane >> 3); const float gsc = gk ? gk[k0 + kk] : 1.0f;
#pragma unroll
        for (int j = 0; j < 4; ++j) scr[kk * 33 + 4 * (lane & 7) + j] = wv[i][j] * gsc; }
    asm volatile("s_waitcnt lgkmcnt(0)" ::: "memory");
    int prow0 = n0;
    if (permute) { const int gl = (n0 & 255) >> 5, wc = gl >> 1, bj = gl & 1; prow0 = (n0 & ~255) + (4 * bj + wc) * 32; }
    const int c = lane & 7;
#pragma unroll
    for (int j = 0; j < 4; ++j) { const int n = (lane >> 3) + 8 * j; const LAS float* s = scr + (8 * c) * 33 + n;
        u32x4 o; o.x = pk2(s[0 * 33], s[1 * 33]); o.y = pk2(s[2 * 33], s[3 * 33]); o.z = pk2(s[4 * 33], s[5 * 33]); o.w = pk2(s[6 * 33], s[7 * 33]);
        *(u32x4*)(WT + (size_t)(prow0 + n) * K + k0 + 8 * c) = o; }
    asm volatile("s_waitcnt lgkmcnt(0)" ::: "memory");
}

__global__ void __launch_bounds__(NWAVES * 64, 2) fwd_kernel(Args args) {
    extern __shared__ __attribute__((aligned(16))) unsigned char lds_raw[];
    LAS unsigned char* lds = (LAS unsigned char*)lds_raw;
    const int tid = threadIdx.x, lane = tid & 63, wid = __builtin_amdgcn_readfirstlane(tid >> 6);
    const int G = gridDim.x, bx = blockIdx.x;
    const int vcu = (G % 8 == 0) ? (bx % 8) * (G / 8) + bx / 8 : bx;
    const int r32 = lane & 31, hi = lane >> 5;
    unsigned char* ws = args.ws;
    const float* x = args.in[0];
    float* out = args.out;
    bf16_t* W0T = (bf16_t*)(ws + WS_W0T); bf16_t* WO0T = (bf16_t*)(ws + WS_WO0T); bf16_t* W1T = (bf16_t*)(ws + WS_W1T); bf16_t* WO1T = (bf16_t*)(ws + WS_WO1T);
    float* ROPE = (float*)(ws + WS_ROPE); float* SS = (float*)(ws + WS_SS);
    bf16_t* XN = (bf16_t*)(ws + WS_XN); bf16_t* MIX = (bf16_t*)(ws + WS_MIX); bf16_t* PROJ = (bf16_t*)(ws + WS_PROJ);
    const int lo = args.ph_lo, hi_ph = args.ph_hi;
#define IN(k) (lo <= (k) && (k) < hi_ph)
    volatile LAS unsigned* xb_st = (volatile LAS unsigned*)(lds + LDS_BYTES - 64);
    if (tid < 2) xb_st[tid] = 0u;
    __syncthreads();
    XcdBarrier xbar; xbar.bar = (unsigned*)ws; xbar.x = 0; xbar.st = xb_st;
    if (hi_ph - lo > 1) xbar = xcd_barrier_post((unsigned*)ws, xb_st);
#define SEAM(k) do { if (IN(k) && IN((k) + 1)) { xcd_barrier(xbar); } } while (0)

    if (IN(0)) {
        LAS float* scr = (LAS float*)(lds + wid * 16384);
        const int gw = vcu * NWAVES + wid, NGW = G * NWAVES;
        constexpr int I_0 = (DM / 64) * (N0 / 32), I_O = (DM / 64) * (DM / 32), I_1 = (DM / 64) * (N1 / 32);
        constexpr int NITEMS = I_0 + I_O + I_1 + I_O;
        for (int it = gw; it < NITEMS; it += NGW) {
            int r = it;
            if (r < I_0) { transpose_item(args.in[2], DM, N0, W0T, true, nullptr, scr, r, lane); continue; } r -= I_0;
            if (r < I_O) { transpose_item(args.in[3], DM, DM, WO0T, false, nullptr, scr, r, lane); continue; } r -= I_O;
            if (r < I_1) { transpose_item(args.in[11], DM, N1, W1T, true, args.in[10], scr, r, lane); continue; } r -= I_1;
            transpose_item(args.in[12], DM, DM, WO1T, false, nullptr, scr, r, lane);
        }
        for (int e = (vcu * NWAVES * 64) + tid; e < SEQ * 32; e += G * NWAVES * 64) {
            const int pos = e >> 5, i = e & 31;
            const float inv = 1.0f / powf(10000.0f, (float)(2 * i) / 64.0f);
            const float ang = (float)pos * inv;
            ROPE[e] = cosf(ang); ROPE[SEQ * 32 + e] = sinf(ang);
        }
        const float* gn = args.in[1];
        for (int mrow = gw; mrow < M_ROWS; mrow += NGW) {
            const f32x4* xr = (const f32x4*)(x + (size_t)mrow * DM) + lane;
            f32x4 v[4]; float s = 0.f;
#pragma unroll
            for (int j = 0; j < 4; ++j) { v[j] = xr[64 * j]; s += (v[j][0] * v[j][0] + v[j][1] * v[j][1]) + (v[j][2] * v[j][2] + v[j][3] * v[j][3]); }
            const float rstd = 1.0f / sqrtf(wave_sum(s) * (1.0f / DM) + EPS);
            unsigned long long* o8 = (unsigned long long*)(XN + (size_t)mrow * DM) + lane;
#pragma unroll
            for (int j = 0; j < 4; ++j) { const f32x4 g4 = *((const f32x4*)gn + lane + 64 * j);
                o8[64 * j] = (unsigned long long)pk2(v[j][0] * rstd * g4[0], v[j][1] * rstd * g4[1]) | ((unsigned long long)pk2(v[j][2] * rstd * g4[2], v[j][3] * rstd * g4[3]) << 32); }
        }
        __syncthreads();
    }
    SEAM(0);

    if (IN(1)) {
        pg8::Gemm g{XN, W0T, M_ROWS, N0, DM}; pg8::StaticOrder S; S.init(M_ROWS, N0, G, bx);
        pg8::EpiProj E{PROJ, N0, 0, args.in[4], args.in[5], args.in[7], args.in[8], ROPE, nullptr};
        pg8::gemm_phase<pg8::EpiProj, pg8::StaticOrder, true, true>(lds, g, S, E);
    }
    SEAM(1);

    if (IN(2)) {
        typedef sa::Lay<2> L;
        LAS char* al = (LAS char*)lds;
        LAS float* wsf = (LAS float*)(al + L::WSF) + wid * 64;
        LAS float* stg = (LAS float*)(al + L::STG + wid * L::STG_W);
        bool norefA, norefB;
        { float gqa = fabsf(args.in[4][lane]), gka = fabsf(args.in[5][lane]), gqb = fabsf(args.in[7][lane]), gkb = fabsf(args.in[8][lane]), bm = 0.f;
          for (int i_ = lane; i_ < 8 * 257; i_ += 64) bm = fmaxf(bm, fabsf(args.in[9][i_]));
#pragma unroll
          for (int o_ = 1; o_ < 64; o_ <<= 1) { gqa = fmaxf(gqa, __shfl_xor(gqa, o_)); gka = fmaxf(gka, __shfl_xor(gka, o_)); gqb = fmaxf(gqb, __shfl_xor(gqb, o_)); gkb = fmaxf(gkb, __shfl_xor(gkb, o_)); bm = fmaxf(bm, __shfl_xor(bm, o_)); }
          norefA = __builtin_amdgcn_readfirstlane((64.0f * C2 * gqa * gka <= 60.0f) ? 1 : 0) != 0;
          norefB = __builtin_amdgcn_readfirstlane((64.0f * C2 * gqb * gkb + 2.0f * LOG2E * bm <= 60.0f) ? 1 : 0) != 0; }
        auto gate_ld = [&](u32x4 (&gt)[4], size_t qrow0, int gcol) {
#pragma unroll
            for (int i = 0; i < 4; ++i) { const int row = i * 8 + (lane >> 3), c8 = lane & 7; gt[i] = *(const u32x4*)(PROJ + (qrow0 + row) * N0 + gcol + c8 * 8); } };
        auto epi_ab = [&](const f32x16 (&o)[2], float scl, size_t qrow0, const u32x4 (&gtv)[4], int mcol) {
            if (hi == 0) wsf[32 + r32] = scl;
#pragma unroll
            for (int g = 0; g < 4; ++g) { const f32x4 s4 = *(const LAS f32x4*)(wsf + 32 + 8 * g + 4 * hi);
#pragma unroll
                for (int d0 = 0; d0 < 2; ++d0)
#pragma unroll
                    for (int j = 0; j < 4; ++j) stg[(8 * g + 4 * hi + j) * 64 + d0 * 32 + r32] = o[d0][4 * g + j] * s4[j]; }
#pragma unroll
            for (int i = 0; i < 4; ++i) { const int row = i * 8 + (lane >> 3), c8 = lane & 7;
                const f32x4 a = *(const LAS f32x4*)(stg + row * 64 + c8 * 8), bb = *(const LAS f32x4*)(stg + row * 64 + c8 * 8 + 4);
                const u32x4 gt = gtv[i];
                u32x4 w; w.x = sa::cvtpk(a[0] * sa::bf_lo(gt.x), a[1] * sa::bf_hi(gt.x)); w.y = sa::cvtpk(a[2] * sa::bf_lo(gt.y), a[3] * sa::bf_hi(gt.y));
                w.z = sa::cvtpk(bb[0] * sa::bf_lo(gt.z), bb[1] * sa::bf_hi(gt.z)); w.w = sa::cvtpk(bb[2] * sa::bf_lo(gt.w), bb[3] * sa::bf_hi(gt.w));
                *(u32x4*)(MIX + (qrow0 + row) * DM + mcol + c8 * 8) = w; }
        };
        bf16x8 qr[4];
        struct GA { int c, b, kvh, hq, t_lo; size_t qrow0; const bf16_t *Qw, *Kh, *Vh; };
        auto geom_a = [&](int id) { GA g; g.c = id & 127; const int bk = id >> 7; g.b = bk >> 1; g.kvh = bk & 1; g.hq = g.kvh * 4 + (wid >> 1);
            g.qrow0 = (size_t)g.b * SEQ + g.c * 64 + (wid & 1) * 32; g.t_lo = g.c >= 2 ? g.c - 2 : 0;
            g.Qw = PROJ + g.qrow0 * N0 + C_AQ + g.hq * 64; g.Kh = PROJ + (size_t)g.b * SEQ * N0 + C_AK + g.kvh * 64; g.Vh = PROJ + (size_t)g.b * SEQ * N0 + C_AV + g.kvh * 64; return g; };
        if (norefA && vcu < BATCH * 2 * 128) { const GA g = geom_a(vcu); sa::pp_prefetch<2>(al, g.Qw, N0, g.Kh + (size_t)g.t_lo * 64 * N0, N0, g.Vh + (size_t)g.t_lo * 64 * N0, N0, g.c + 1 - g.t_lo, qr); }
        for (int id = vcu; id < BATCH * 2 * 128; id += G) {
            const GA g = geom_a(id);
            f32x16 o[2]; float m, l;
            u32x4 gtv[4]; gate_ld(gtv, g.qrow0, C_AG + g.hq * 64);
            if (norefA) {
                sa::stream_pp<2, true, 0>(al, g.Kh + (size_t)g.t_lo * 64 * N0, N0, g.Vh + (size_t)g.t_lo * 64 * N0, N0, g.c + 1 - g.t_lo, 0, g.c - g.t_lo, 0, 0, qr, o, l, m);
                if (id + G < BATCH * 2 * 128) { const GA n = geom_a(id + G);
                    sa::pp_prefetch<2>(al, n.Qw, N0, n.Kh + (size_t)n.t_lo * 64 * N0, N0, n.Vh + (size_t)n.t_lo * 64 * N0, N0, n.c + 1 - n.t_lo, qr); }
            } else sa::stream<2, 0>(al, g.Qw, N0, g.Kh, N0, g.Vh, N0, g.t_lo, g.c + 1, g.t_lo, g.c, 0, 0, o, m, l);
            float lt = sa::swap_sum(l);
            const float s2 = args.in[6][g.hq] * LOG2E, mf = fmaxf(m, s2), e1 = __builtin_amdgcn_exp2f(m - mf);
            lt = lt * e1 + __builtin_amdgcn_exp2f(s2 - mf);
            epi_ab(o, e1 / lt, g.qrow0, gtv, g.hq * 64);
        }
        struct GB { int b, h, c0, cw, t_lo, w_lo; size_t qrow0; const bf16_t *Qw, *Kh, *Vh; };
        auto geom_b = [&](int id) { GB g; const int cg4 = id & 31, bh = id >> 5; g.b = bh >> 3; g.h = bh & 7; g.c0 = cg4 * 4; g.cw = g.c0 + (wid >> 1);
            g.qrow0 = (size_t)g.b * SEQ + g.cw * 64 + (wid & 1) * 32; g.t_lo = g.c0 >= 8 ? g.c0 - 8 : 0; g.w_lo = g.cw >= 8 ? g.cw - 8 : 0;
            g.Qw = PROJ + g.qrow0 * N0 + C_BQ + g.h * 64; g.Kh = PROJ + (size_t)g.b * SEQ * N0 + C_BK + g.h * 64; g.Vh = PROJ + (size_t)g.b * SEQ * N0 + C_BV + g.h * 64; return g; };
        LAS float* tabw = (LAS float*)(al + L::TAB);
        auto fill_tab = [&](int h) { if (tid < 320) tabw[tid] = (args.in[9][h * 257 + (tid < 256 ? tid : 256)] - args.in[9][h * 257 + 256]) * LOG2E; };
        if (norefB && vcu < BATCH * 8 * 32) { const GB g = geom_b(vcu); fill_tab(g.h);
            sa::pp_prefetch<2>(al, g.Qw, N0, g.Kh + (size_t)g.t_lo * 64 * N0, N0, g.Vh + (size_t)g.t_lo * 64 * N0, N0, g.c0 + 4 - g.t_lo, qr); }
        for (int id = vcu; id < BATCH * 8 * 32; id += G) {
            const GB g = geom_b(id);
            f32x16 o[2]; float m, l;
            u32x4 gtv[4]; gate_ld(gtv, g.qrow0, C_BG + g.h * 64);
            if (norefB) {
                sa::stream_pp<2, true, 1>(al, g.Kh + (size_t)g.t_lo * 64 * N0, N0, g.Vh + (size_t)g.t_lo * 64 * N0, N0, g.c0 + 4 - g.t_lo, g.w_lo - g.t_lo, g.cw - g.t_lo, g.cw - g.t_lo, (wid & 1) * 32, qr, o, l, m);
                if (id + G < BATCH * 8 * 32) { const GB n = geom_b(id + G); fill_tab(n.h);
                    sa::pp_prefetch<2>(al, n.Qw, N0, n.Kh + (size_t)n.t_lo * 64 * N0, N0, n.Vh + (size_t)n.t_lo * 64 * N0, N0, n.c0 + 4 - n.t_lo, qr); }
            } else { fill_tab(g.h); sa::stream<2, 1>(al, g.Qw, N0, g.Kh, N0, g.Vh, N0, g.t_lo, g.c0 + 4, g.w_lo, g.cw, g.cw, (wid & 1) * 32, o, m, l); }
            epi_ab(o, 1.0f / sa::swap_sum(l), g.qrow0, gtv, 512 + g.h * 64);
        }
        asm volatile("s_waitcnt vmcnt(0) lgkmcnt(0)" ::: "memory");
        __syncthreads();
    }
    SEAM(2);

    if (IN(3)) {
        pg8::Gemm g{MIX, WO0T, M_ROWS, DM, DM}; pg8::StaticOrder S; S.init(M_ROWS, DM, G, bx);
        pg8::EpiRes E{x, nullptr, nullptr, XN, SS};
        pg8::gemm_phase<pg8::EpiRes, pg8::StaticOrder, true, true>(lds, g, S, E);
    }
    SEAM(3);

    if (IN(4)) {
        pg8::Gemm g{XN, W1T, M_ROWS, N1, DM}; pg8::StaticOrder S; S.init(M_ROWS, N1, G, bx);
        pg8::EpiProj E{PROJ, N1, 1, args.in[13], args.in[14], nullptr, nullptr, ROPE, SS};
        pg8::gemm_phase<pg8::EpiProj, pg8::StaticOrder, true, true>(lds, g, S, E);
    }
    SEAM(4);

    if (IN(5)) {
        typedef sa::Lay<4> L;
        LAS char* al = (LAS char*)lds;
        float lam;
        { const float a = args.in[15][lane] * args.in[16][lane], bq = args.in[17][lane] * args.in[18][lane];
          lam = __expf(wave_sum(a)) - __expf(wave_sum(bq)) + LAMBDA_INIT; }
        const float* subg = args.in[19];
        bool noref;
        { float gq = fabsf(args.in[13][lane]), gk = fabsf(args.in[14][lane]);
#pragma unroll
          for (int o_ = 1; o_ < 64; o_ <<= 1) { gq = fmaxf(gq, __shfl_xor(gq, o_)); gk = fmaxf(gk, __shfl_xor(gk, o_)); }
          noref = __builtin_amdgcn_readfirstlane((64.0f * C2 * gq * gk <= 60.0f) ? 1 : 0) != 0; }
        const bf16_t* Q1 = PROJ; const bf16_t* K1 = PROJ + (size_t)M_ROWS * 1024; const bf16_t* V1 = PROJ + (size_t)M_ROWS * 2048; const bf16_t* G1 = PROJ + (size_t)M_ROWS * 3072;
        struct GC { int b, h, qb, cw, T; size_t qrow0; const bf16_t *Qp, *Kp, *Vh; };
        auto geom_c = [&](int id, int pass) { GC g; const int i = id >> 8, v = id & 255, bh = v >> 3, s = v & 7; g.b = bh >> 3; g.h = bh & 7;
            g.qb = (i == 0) ? s : (i == 1) ? 15 - s : (i == 2) ? 16 + s : 31 - s; g.cw = g.qb * 4 + (wid >> 1); g.T = g.qb * 4 + 4;
            g.qrow0 = (size_t)g.b * SEQ + g.qb * 256 + wid * 32; const int vh = 2 * g.h + 1 - pass;
            g.Qp = Q1 + ((size_t)(g.b * 16 + vh) * SEQ + g.qb * 256 + wid * 32) * 64; g.Kp = K1 + (size_t)(g.b * 16 + vh) * SEQ * 64; g.Vh = V1 + (size_t)(g.b * 8 + g.h) * SEQ * 128; return g; };
        bf16x8 qr[4];
        if (vcu < BATCH * 8 * 32) { const GC g = geom_c(vcu, 0); sa::pp_prefetch<4>(al, g.Qp, 64, g.Kp, 64, g.Vh, 128, g.T, qr); }
        for (int id = vcu; id < BATCH * 8 * 32; id += G) {
            const GC g0 = geom_c(id, 0);
            const int h = g0.h; const size_t qrow0 = g0.qrow0;
            f32x16 o[4]; float l, mref;
#pragma clang loop unroll(disable)
            for (int pass = 0; pass < 2; ++pass) {
                const GC g = geom_c(id, pass);
                if (noref) sa::stream_pp<4, true, 0>(al, g.Kp, 64, g.Vh, 128, g.T, 0, g.cw, 0, 0, qr, o, l, mref);
                else sa::stream_pp<4, false, 0>(al, g.Kp, 64, g.Vh, 128, g.T, 0, g.cw, 0, 0, qr, o, l, mref);
                if (pass == 0) { const GC n = geom_c(id, 1); sa::pp_prefetch<4>(al, n.Qp, 64, n.Kp, 64, n.Vh, 128, n.T, qr); }
                else if (id + G < BATCH * 8 * 32) { const GC n = geom_c(id + G, 0); sa::pp_prefetch<4>(al, n.Qp, 64, n.Kp, 64, n.Vh, 128, n.T, qr); }
                if (pass == 0) {
                    const float scl = 1.0f / sa::swap_sum(l);
                    int le = lane; asm volatile("" : "+v"(le));
                    const int r32e = le & 31, hie = le >> 5;
                    LAS float* wsfe = (LAS float*)(al + L::WSF) + wid * 64;
                    LAS unsigned* parke = (LAS unsigned*)(al + L::STG + wid * L::STG_W) + le;
                    if (hie == 0) wsfe[32 + r32e] = scl;
#pragma unroll
                    for (int g = 0; g < 4; ++g) { const f32x4 s4 = *(const LAS f32x4*)(wsfe + 32 + 8 * g + 4 * hie);
#pragma unroll
                        for (int d0 = 0; d0 < 4; ++d0) { parke[(d0 * 8 + 2 * g) * 64] = sa::cvtpk(o[d0][4 * g] * s4[0], o[d0][4 * g + 1] * s4[1]); parke[(d0 * 8 + 2 * g + 1) * 64] = sa::cvtpk(o[d0][4 * g + 2] * s4[2], o[d0][4 * g + 3] * s4[3]); } }
                }
            }
            int le = lane; asm volatile("" : "+v"(le));
            const int r32e = le & 31, hie = le >> 5;
            LAS float* wsfe = (LAS float*)(al + L::WSF) + wid * 64;
            LAS float* stge = (LAS float*)(al + L::STG + wid * L::STG_W);
            const LAS unsigned* parke = (const LAS unsigned*)stge + le;
            unsigned o2p[4][8];
#pragma unroll
            for (int d0 = 0; d0 < 4; ++d0)
#pragma unroll
                for (int k = 0; k < 8; ++k) o2p[d0][k] = parke[(d0 * 8 + k) * 64];
            asm volatile("s_waitcnt lgkmcnt(0)" ::: "memory");
            const float scl = 1.0f / sa::swap_sum(l);
            if (hie == 0) wsfe[32 + r32e] = scl;
#pragma unroll
            for (int rd = 0; rd < 2; ++rd) {
#pragma unroll
                for (int gg = 0; gg < 2; ++gg) { const int g = 2 * rd + gg; const f32x4 s4 = *(const LAS f32x4*)(wsfe + 32 + 8 * g + 4 * hie);
#pragma unroll
                    for (int d0 = 0; d0 < 4; ++d0)
#pragma unroll
                        for (int j = 0; j < 4; ++j) { const unsigned w2 = o2p[d0][2 * g + (j >> 1)]; const float o2 = (j & 1) ? sa::bf_hi(w2) : sa::bf_lo(w2);
                            stge[(8 * gg + 4 * hie + j) * 128 + d0 * 32 + r32e] = o[d0][4 * g + j] * s4[j] - lam * o2; } }
#pragma unroll
                for (int ii = 0; ii < 4; ++ii) { const int row = ii * 4 + (le >> 4), c8 = le & 15;
                    const f32x4 a = *(const LAS f32x4*)(stge + row * 128 + c8 * 8), bb = *(const LAS f32x4*)(stge + row * 128 + c8 * 8 + 4);
                    float q = (a[0] * a[0] + a[1] * a[1]) + (a[2] * a[2] + a[3] * a[3]) + (bb[0] * bb[0] + bb[1] * bb[1]) + (bb[2] * bb[2] + bb[3] * bb[3]);
                    q += __shfl_xor(q, 1); q += __shfl_xor(q, 2); q += __shfl_xor(q, 4); q += __shfl_xor(q, 8);
                    const float rn = (1.0f - LAMBDA_INIT) / sqrtf(q * (1.0f / 128.0f) + EPS);
                    const f32x4 g0 = *(const f32x4*)(subg + c8 * 8), g1 = *(const f32x4*)(subg + c8 * 8 + 4);
                    const size_t grow = qrow0 + 16 * rd + row;
                    const u32x4 gt = *(const u32x4*)(G1 + grow * 1024 + h * 128 + c8 * 8);
                    u32x4 w; w.x = sa::cvtpk(a[0] * rn * g0[0] * sa::bf_lo(gt.x), a[1] * rn * g0[1] * sa::bf_hi(gt.x)); w.y = sa::cvtpk(a[2] * rn * g0[2] * sa::bf_lo(gt.y), a[3] * rn * g0[3] * sa::bf_hi(gt.y));
                    w.z = sa::cvtpk(bb[0] * rn * g1[0] * sa::bf_lo(gt.z), bb[1] * rn * g1[1] * sa::bf_hi(gt.z)); w.w = sa::cvtpk(bb[2] * rn * g1[2] * sa::bf_lo(gt.w), bb[3] * rn * g1[3] * sa::bf_hi(gt.w));
                    *(u32x4*)(MIX + grow * DM + h * 128 + c8 * 8) = w; }
            }
        }
        asm volatile("s_waitcnt vmcnt(0) lgkmcnt(0)" ::: "memory");
        __syncthreads();
    }
    SEAM(5);

    if (IN(6)) {
        pg8::Gemm g{MIX, WO1T, M_ROWS, DM, DM}; pg8::StaticOrder S; S.init(M_ROWS, DM, G, bx);
        pg8::EpiRes E{nullptr, XN, out, nullptr, nullptr};
        pg8::gemm_phase<pg8::EpiRes, pg8::StaticOrder, true, true>(lds, g, S, E);
    }
#undef IN
#undef SEAM
}

extern "C" void kernel_launch(void* const* d_in, const int* in_sizes, int n_in, void* d_out, int out_size, void* d_ws, size_t ws_size, hipStream_t stream) {
    static int grid = 0;
    if (grid == 0) {
        if (n_in != 20 || in_sizes[0] != M_ROWS * DM || out_size != M_ROWS * DM || ws_size < WS_END) {
            fprintf(stderr, "kernel_launch: unexpected problem (n_in %d, in0 %d, out %d, ws %zu; need ws >= %zu); nothing launched\n", n_in, n_in > 0 ? in_sizes[0] : -1, out_size, ws_size, (size_t)WS_END);
            grid = -1; return; }
        int dev = 0, cus = 0, per_cu = 0;
        if (hipGetDevice(&dev) != hipSuccess || hipDeviceGetAttribute(&cus, hipDeviceAttributeMultiprocessorCount, dev) != hipSuccess) { fprintf(stderr, "kernel_launch: device query failed\n"); grid = -1; return; }
        if (hipFuncSetAttribute((const void*)fwd_kernel, hipFuncAttributeMaxDynamicSharedMemorySize, LDS_BYTES) != hipSuccess) { fprintf(stderr, "kernel_launch: hipFuncSetAttribute failed\n"); grid = -1; return; }
        if (hipOccupancyMaxActiveBlocksPerMultiprocessor(&per_cu, (const void*)fwd_kernel, NWAVES * 64, LDS_BYTES) != hipSuccess || per_cu < 1) {
            fprintf(stderr, "kernel_launch: the occupancy query admits %d workgroups of this kernel per CU; nothing launched\n", per_cu); (void)hipGetLastError(); grid = -1; return; }
        grid = cus * (per_cu < 1 ? per_cu : 1);
    }
    if (grid < 0) return;
    if (hipMemsetAsync(d_ws, 0, XCD_BAR_WORDS * 4, stream) != hipSuccess) { fprintf(stderr, "kernel_launch: hipMemsetAsync of the barrier words failed\n"); return; }
    Args a{};
    for (int i = 0; i < 20; ++i) a.in[i] = (const float*)d_in[i];
    a.out = (float*)d_out; a.ws = (unsigned char*)d_ws;
#if MK_N_LAUNCHES == 1
    a.ph_lo = 0; a.ph_hi = N_PHASES;
    void* kargs[] = {&a};
    hipError_t e = hipLaunchCooperativeKernel((const void*)fwd_kernel, dim3(grid), dim3(NWAVES * 64), kargs, LDS_BYTES, stream);
    if (e != hipSuccess) fprintf(stderr, "kernel_launch: cooperative launch failed: %s (grid %d)\n", hipGetErrorString(e), grid);
#else
    for (int p = 0; p < N_PHASES; ++p) {
        a.ph_lo = p; a.ph_hi = p + 1;
        for (int rep = 1; rep < (p == PROBE_PHASE ? PROBE_REPS : 1); ++rep) hipLaunchKernelGGL(fwd_kernel, dim3(grid), dim3(NWAVES * 64), LDS_BYTES, stream, a);
        hipLaunchKernelGGL(fwd_kernel, dim3(grid), dim3(NWAVES * 64), LDS_BYTES, stream, a);
        const hipError_t le = hipPeekAtLastError();
        if (le != hipSuccess) { fprintf(stderr, "kernel_launch: launch %d failed: %s\n", p, hipGetErrorName(le)); break; }
    }
#endif
}
```

```cpp
#include <hip/hip_runtime.h>
#include <cstdio>
#include <cstdint>

#ifndef MK_N_LAUNCHES
#define MK_N_LAUNCHES 1
#endif

#ifndef PROBE_PHASE
#define PROBE_PHASE -1
#endif
#ifndef PROBE_REPS
#define PROBE_REPS 2
#endif

#define LAS __attribute__((address_space(3)))
typedef unsigned short bf16_t;
typedef short bf16x8 __attribute__((ext_vector_type(8)));
typedef short s16x4 __attribute__((ext_vector_type(4)));
typedef float f32x4 __attribute__((ext_vector_type(4)));
typedef float f32x16 __attribute__((ext_vector_type(16)));
typedef unsigned u32x4 __attribute__((ext_vector_type(4)));
typedef unsigned u32x2 __attribute__((ext_vector_type(2)));

constexpr int BATCH = 4, SEQ = 8192, DM = 1024, M_ROWS = BATCH * SEQ;
constexpr int N0 = 3328, N1 = 4096;
constexpr float EPS = 1e-6f;
constexpr float LOG2E = 1.4426950408889634f;
constexpr float C2 = 0.125f * LOG2E;
constexpr float LAMBDA_INIT = 0.35550906759096927f;
constexpr int C_AQ = 0, C_AK = 512, C_AV = 640, C_AG = 768, C_BQ = 1280, C_BK = 1792, C_BV = 2304, C_BG = 2816;
constexpr int C_CQ = 0, C_CK = 1024, C_CV = 2048, C_CG = 3072;

constexpr size_t MiB = 1u << 20;
constexpr size_t WS_W0T = 1 * MiB;
constexpr size_t WS_WO0T = 8 * MiB;
constexpr size_t WS_W1T = 10 * MiB;
constexpr size_t WS_WO1T = 18 * MiB;
constexpr size_t WS_ROPE = 20 * MiB;
constexpr size_t WS_SS = 22 * MiB;
constexpr size_t WS_XN = 32 * MiB;
constexpr size_t WS_MIX = 96 * MiB;
constexpr size_t WS_PROJ = 160 * MiB;
constexpr size_t WS_END = 416 * MiB;

namespace pg8 {
constexpr int BM = 256, BK = 64, HALF = 128, HTB = HALF * BK * 2, STAGE_BYTES = 8 * HTB, NXCD = 8, WGM = 4;
__host__ __device__ __forceinline__ int lds_byte(int r, int c) { const int st = (r >> 4) * 2 + (c >> 5), rr = r & 15, cc = c & 31, ob = rr * 64 + cc * 2; return st * 1024 + (ob ^ (((ob >> 9) & 1) << 5)); }
__host__ __device__ __forceinline__ void stage_rc(int b, int& R, int& C) { const int st = b / 1024, sb = b % 1024, swz = sb ^ (((sb >> 9) & 1) << 5); R = (st >> 1) * 16 + swz / 64; C = (st & 1) * 32 + (swz % 64) / 2; }
__host__ __device__ __forceinline__ int perm32(int rho) { const int n = rho >> 4, i = rho & 15; return 8 * (i >> 2) + 4 * n + (i & 3); }

struct Unit { int pm, pn; };
struct Gemm { const bf16_t* A; const bf16_t* Bt; int M, N, K; };

struct StaticOrder {
    int nM, nN, nwg, G, c;
    __host__ __device__ void init(int M, int N, int G_, int c_) { nM = M / BM; nN = N / BM; nwg = nM * nN; G = G_; c = c_; }
    __host__ __device__ bool next(int i, Unit& u) const {
        const long L = (long)i * G + c; if (L >= nwg) return false;
        int wgid = (int)L; { const int q = nwg / NXCD, r = nwg % NXCD, xcd = wgid % NXCD, off = wgid / NXCD; wgid = (xcd < r ? xcd * (q + 1) : r * (q + 1) + (xcd - r) * q) + off; }
        const int nig = WGM * nN, gid = wgid / nig, fm = gid * WGM, gsz = (nM - fm) < WGM ? (nM - fm) : WGM;
        u.pm = fm + ((wgid % nig) % gsz); u.pn = (wgid % nig) / gsz; return true;
    }
    __device__ __forceinline__ void a_ready(const Unit&) const {}
    __device__ __forceinline__ void done(const Unit&) const {}
};

__device__ __forceinline__ unsigned cvt_pk_bf16(float lo, float hi) { unsigned r; asm volatile("s_nop 0\n\tv_cvt_pk_bf16_f32 %0, %1, %2" : "=v"(r) : "v"(lo), "v"(hi)); return r; }

struct EpiProj {
    static constexpr bool PERM = true, AFTER_DRAIN = false;
    bf16_t* O; int ldc; int layer;
    const float* g_q; const float* g_k; const float* g_q2; const float* g_k2;
    const float* rope;
    const float* ss;
    __device__ __forceinline__ void operator()(const f32x4 (&acc)[2][2][4][2], const Unit& u, int wr, int wc, int fr, int fq) const {
        const int gh = 4 * u.pn + wc;
        const float* gp = nullptr; bool rope_on = false, silu_on = false; float sc = 1.f;
        if (layer == 0) {
            if (gh < 8) { gp = g_q; rope_on = true; sc = C2; } else if (gh < 10) { gp = g_k; rope_on = true; } else if (gh < 12) {} else if (gh < 20) { silu_on = true; }
            else if (gh < 28) { gp = g_q2; sc = C2; } else if (gh < 36) { gp = g_k2; } else if (gh < 44) {} else { silu_on = true; }
        } else {
            if (gh < 16) { gp = g_q; rope_on = true; sc = C2; } else if (gh < 32) { gp = g_k; rope_on = true; } else if (gh < 48) {} else { silu_on = true; }
        }
        f32x4 gv[2][2];
#pragma unroll
        for (int bj = 0; bj < 2; ++bj)
#pragma unroll
            for (int n = 0; n < 2; ++n) gv[bj][n] = gp ? *(const f32x4*)(gp + 32 * bj + 8 * fq + 4 * n) : (f32x4){1.f, 1.f, 1.f, 1.f};
        bf16_t* dbuf = O; int NH = 1, hidx = 0, RP = ldc, coff = u.pn * BM + 64 * wc;
        if (layer == 1) {
            if (gh < 16) { dbuf = O; NH = 16; hidx = gh; RP = 64; coff = 0; }
            else if (gh < 32) { dbuf = O + (size_t)M_ROWS * 1024; NH = 16; hidx = gh - 16; RP = 64; coff = 0; }
            else if (gh < 48) { dbuf = O + (size_t)M_ROWS * 2048; NH = 8; hidx = (gh - 32) >> 1; RP = 128; coff = ((gh - 32) & 1) * 64; }
            else { dbuf = O + (size_t)M_ROWS * 3072; NH = 1; hidx = 0; RP = 1024; coff = (gh - 48) * 64; }
        }
        const int colo = coff + 8 * fq;
        const int row0 = u.pm * BM + wr * 64 + fr;
        float rs[8];
        if (ss) {
            f32x4 p4[8];
#pragma unroll
            for (int g = 0; g < 8; ++g) p4[g] = *(const f32x4*)(ss + (size_t)(row0 + (g >> 2) * HALF + (g & 3) * 16) * 16 + 4 * fq);
#pragma unroll
            for (int g = 0; g < 8; ++g) { float q = (p4[g][0] + p4[g][1]) + (p4[g][2] + p4[g][3]); q += __shfl_xor(q, 16); q += __shfl_xor(q, 32); rs[g] = __builtin_amdgcn_rsqf(q * (1.0f / 1024.0f) + EPS); }
        } else {
#pragma unroll
            for (int g = 0; g < 8; ++g) rs[g] = 1.f;
        }
        f32x4 rc[3][2][2];
        const float* rtab = rope + 8 * fq;
#define EP_ROPE_LD(g) do { const int pos_ = (row0 + ((g) >> 2) * HALF + ((g) & 3) * 16) & (SEQ - 1); _Pragma("unroll") for (int n = 0; n < 2; ++n) { \
            rc[(g) % 3][n][0] = *(const f32x4*)(rtab + (size_t)pos_ * 32 + 4 * n); rc[(g) % 3][n][1] = *(const f32x4*)(rtab + (size_t)SEQ * 32 + (size_t)pos_ * 32 + 4 * n); } } while (0)
        if (rope_on) { EP_ROPE_LD(0); EP_ROPE_LD(1); }
#pragma unroll
        for (int g = 0; g < 8; ++g) {
            const int ai = g >> 2, m = g & 3;
            const int row = row0 + ai * HALF + m * 16;
            const size_t drow = (size_t)((row >> 13) * NH + hidx) * SEQ + (row & (SEQ - 1));
            if (rope_on && g + 2 < 8) EP_ROPE_LD(g + 2);
            f32x4 v[2][2];
#pragma unroll
            for (int bj = 0; bj < 2; ++bj)
#pragma unroll
                for (int n = 0; n < 2; ++n) v[bj][n] = acc[ai][bj][m][n] * rs[g];
            if (gp) {
                float q = 0.f;
#pragma unroll
                for (int bj = 0; bj < 2; ++bj)
#pragma unroll
                    for (int n = 0; n < 2; ++n) { const f32x4 x = v[bj][n]; q += (x[0] * x[0] + x[1] * x[1]) + (x[2] * x[2] + x[3] * x[3]); }
                q += __shfl_xor(q, 16); q += __shfl_xor(q, 32);
                const float rn = __builtin_amdgcn_rsqf(q * (1.0f / 64.0f) + EPS);
#pragma unroll
                for (int bj = 0; bj < 2; ++bj)
#pragma unroll
                    for (int n = 0; n < 2; ++n) v[bj][n] = v[bj][n] * rn * gv[bj][n];
            }
            if (rope_on) {
#pragma unroll
                for (int n = 0; n < 2; ++n) {
                    const f32x4 c = rc[g % 3][n][0], sn = rc[g % 3][n][1];
                    const f32x4 x1 = v[0][n], x2 = v[1][n];
                    v[0][n] = x1 * c - x2 * sn; v[1][n] = x2 * c + x1 * sn;
                }
            }
#pragma unroll
            for (int bj = 0; bj < 2; ++bj) {
                f32x4 a = v[bj][0] * sc, b = v[bj][1] * sc;
                if (silu_on) {
#pragma unroll
                    for (int j = 0; j < 4; ++j) { a[j] = a[j] * __builtin_amdgcn_rcpf(1.0f + __builtin_amdgcn_exp2f(-LOG2E * a[j])); b[j] = b[j] * __builtin_amdgcn_rcpf(1.0f + __builtin_amdgcn_exp2f(-LOG2E * b[j])); }
                }
                u32x4 w; w.x = cvt_pk_bf16(a[0], a[1]); w.y = cvt_pk_bf16(a[2], a[3]); w.z = cvt_pk_bf16(b[0], b[1]); w.w = cvt_pk_bf16(b[2], b[3]);
                *(u32x4*)(dbuf + drow * RP + colo + 32 * bj) = w;
            }
        }
#undef EP_ROPE_LD
    }
};
struct EpiRes {
    static constexpr bool PERM = true, AFTER_DRAIN = false;
    const float* base; const bf16_t* base16; float* out; bf16_t* xb; float* ss;
    __device__ __forceinline__ void operator()(const f32x4 (&acc)[2][2][4][2], const Unit& u, int wr, int wc, int fr, int fq) const {
#pragma unroll
        for (int ai = 0; ai < 2; ++ai)
#pragma unroll
            for (int m = 0; m < 4; ++m) {
                const int row = u.pm * BM + ai * HALF + wr * 64 + m * 16 + fr;
                float q = 0.f;
#pragma unroll
                for (int bj = 0; bj < 2; ++bj) {
                    const size_t off = (size_t)row * DM + u.pn * BM + bj * HALF + wc * 32 + 8 * fq;
                    f32x4 b0, b1;
                    if (base16) { const u32x4 w = *(const u32x4*)(base16 + off);
                        b0 = (f32x4){__uint_as_float(w.x << 16), __uint_as_float(w.x & 0xffff0000u), __uint_as_float(w.y << 16), __uint_as_float(w.y & 0xffff0000u)};
                        b1 = (f32x4){__uint_as_float(w.z << 16), __uint_as_float(w.z & 0xffff0000u), __uint_as_float(w.w << 16), __uint_as_float(w.w & 0xffff0000u)}; }
                    else { b0 = *(const f32x4*)(base + off); b1 = *(const f32x4*)(base + off + 4); }
                    const f32x4 a = acc[ai][bj][m][0] + b0, b = acc[ai][bj][m][1] + b1;
                    if (out) { *(f32x4*)(out + off) = a; *(f32x4*)(out + off + 4) = b; }
                    q += (a[0] * a[0] + a[1] * a[1]) + (a[2] * a[2] + a[3] * a[3]) + (b[0] * b[0] + b[1] * b[1]) + (b[2] * b[2] + b[3] * b[3]);
                    if (xb) { u32x4 w; w.x = cvt_pk_bf16(a[0], a[1]); w.y = cvt_pk_bf16(a[2], a[3]); w.z = cvt_pk_bf16(b[0], b[1]); w.w = cvt_pk_bf16(b[2], b[3]); *(u32x4*)(xb + off) = w; }
                }
                if (ss) { q += __shfl_xor(q, 16); q += __shfl_xor(q, 32); if (fq == 0) ss[(size_t)row * 16 + u.pn * 4 + wc] = q; }
            }
    }
};

template <class Epi, class Sched, bool ALIGN_EPI = false, bool SP2 = false>
__device__ __forceinline__ void gemm_phase(LAS unsigned char* lds, const Gemm g, const Sched& S, const Epi& E) {
    const int tid = threadIdx.x, wid = __builtin_amdgcn_readfirstlane(tid >> 6), lane = tid & 63, wr = wid >> 2, wc = wid & 3, fr = lane & 15, fq = lane >> 4;
    const int K = g.K, nt = K / BK;
    unsigned voffA[2], voffB[2];
#pragma unroll
    for (int i = 0; i < 2; ++i) { int R, C; stage_rc(tid * 16 + i * 8192, R, C); const int Rb = Epi::PERM ? ((R & ~31) + perm32(R & 31)) : R;
        voffA[i] = (unsigned)(R * K + C) * 2u; voffB[i] = (unsigned)(Rb * K + C) * 2u; }
    const size_t kstep = (size_t)(BK * 2);
    const size_t hstep = (size_t)HALF * K * 2;
    const size_t tstep = 2 * hstep;
    const unsigned ldsw = (unsigned)wid * 1024u;
    const int aoff = lds_byte(wr * 64 + fr, fq * 8), boff = lds_byte(wc * 32 + fr, fq * 8);
#define PG8_SA(b, h) (((b) * 2 + (h)) * HTB)
#define PG8_SB(b, h) ((4 + (b) * 2 + (h)) * HTB)
#define PG8_STAGE(bufoff, gbase, voff) do { _Pragma("unroll") for (int _i = 0; _i < 2; ++_i) \
        __builtin_amdgcn_global_load_lds((const unsigned*)((const char*)(gbase) + (voff)[_i]), (LAS unsigned*)(lds + (bufoff) + ldsw + _i * 8192), 16, 0, 0); } while (0)
#define PG8_LDA(dst, b, h) do { _Pragma("unroll") for (int m = 0; m < 4; ++m) _Pragma("unroll") for (int k = 0; k < 2; ++k) dst[m][k] = *(const LAS bf16x8*)(lds + PG8_SA(b, h) + aoff + m * 2048 + k * 1024); } while (0)
#define PG8_LDB(dst, b, h) do { _Pragma("unroll") for (int n = 0; n < 2; ++n) _Pragma("unroll") for (int k = 0; k < 2; ++k) dst[n][k] = *(const LAS bf16x8*)(lds + PG8_SB(b, h) + boff + n * 2048 + k * 1024); } while (0)
#define PG8_MMA(ai, bj, At, Bt) do { __builtin_amdgcn_s_setprio(1); _Pragma("unroll") for (int m = 0; m < 4; ++m) _Pragma("unroll") for (int n = 0; n < 2; ++n) _Pragma("unroll") for (int k = 0; k < 2; ++k) \
        acc[ai][bj][m][n] = __builtin_amdgcn_mfma_f32_16x16x32_bf16(Bt[n][k], At[m][k], acc[ai][bj][m][n], 0, 0, 0); __builtin_amdgcn_s_setprio(0); } while (0)
#define PG8_WAIT_V(n) asm volatile("s_waitcnt vmcnt(" #n ")" ::: "memory")
#define PG8_WAIT_L(n) asm volatile("s_waitcnt lgkmcnt(" #n ")" ::: "memory")
#define PG8_BAR __builtin_amdgcn_s_barrier()
#define PG8_SCHED __builtin_amdgcn_sched_barrier(0)
    Unit cur, nxt; int ui = 0;
    if (!S.next(0, cur)) return;
    f32x4 acc[2][2][4][2];
#pragma unroll
    for (int a = 0; a < 2; ++a)
#pragma unroll
        for (int b = 0; b < 2; ++b)
#pragma unroll
            for (int m = 0; m < 4; ++m)
#pragma unroll
                for (int n = 0; n < 2; ++n) acc[a][b][m][n] = (f32x4){0.f, 0.f, 0.f, 0.f};
    bf16x8 At[4][2], B0[2][2], B1[2][2];
    const char* cA = (const char*)g.A + (size_t)cur.pm * tstep; const char* cB = (const char*)g.Bt + (size_t)cur.pn * tstep;
    S.a_ready(cur);
    if constexpr (SP2) {
        PG8_STAGE(PG8_SB(0, 0), cB, voffB); PG8_STAGE(PG8_SB(0, 1), cB + hstep, voffB); PG8_STAGE(PG8_SA(0, 0), cA, voffA); PG8_STAGE(PG8_SA(0, 1), cA + hstep, voffA);
        if (wr == 1) PG8_BAR;
        PG8_WAIT_V(2); PG8_BAR;
        PG8_STAGE(PG8_SB(1, 0), cB + kstep, voffB); PG8_STAGE(PG8_SA(1, 0), cA + kstep, voffA); PG8_STAGE(PG8_SB(1, 1), cB + hstep + kstep, voffB);
        PG8_WAIT_V(6); PG8_BAR;
    } else {
        PG8_STAGE(PG8_SB(0, 0), cB, voffB); PG8_STAGE(PG8_SA(0, 0), cA, voffA); PG8_STAGE(PG8_SB(0, 1), cB + hstep, voffB); PG8_STAGE(PG8_SA(0, 1), cA + hstep, voffA);
        if (wr == 1) PG8_BAR;
        PG8_WAIT_V(4); PG8_BAR;
        PG8_STAGE(PG8_SB(1, 0), cB + kstep, voffB); PG8_STAGE(PG8_SA(1, 0), cA + kstep, voffA); PG8_STAGE(PG8_SB(1, 1), cB + hstep + kstep, voffB);
        PG8_WAIT_V(6); PG8_BAR;
    }
    for (;;) {
        const bool has_next = S.next(ui + 1, nxt);
        const char* nA = has_next ? (const char*)g.A + (size_t)nxt.pm * tstep : cA; const char* nB = has_next ? (const char*)g.Bt + (size_t)nxt.pn * tstep : cB;
        for (int t = 0; t < nt; t += 2) {
            const bool last = (t == nt - 2);
            const char* a1 = cA + (size_t)(t + 1) * kstep;
            const char* a2 = last ? nA : cA + (size_t)(t + 2) * kstep; const char* b2 = last ? nB : cB + (size_t)(t + 2) * kstep;
            const char* a3 = a2 + kstep; const char* b3 = b2 + kstep;
            if (last && has_next) S.a_ready(nxt);
            if constexpr (SP2) {
            PG8_LDB(B0, 0, 0); PG8_LDB(B1, 0, 1); PG8_SCHED; PG8_LDA(At, 0, 0); PG8_STAGE(PG8_SA(1, 1), a1 + hstep, voffA);
            PG8_WAIT_V(8); PG8_WAIT_L(0); PG8_BAR; PG8_MMA(0, 0, At, B0); PG8_MMA(0, 1, At, B1); PG8_BAR; PG8_SCHED;
            PG8_LDA(At, 0, 1); PG8_STAGE(PG8_SB(0, 0), b2, voffB); PG8_STAGE(PG8_SB(0, 1), b2 + hstep, voffB); PG8_STAGE(PG8_SA(0, 0), a2, voffA);
            PG8_WAIT_V(8); PG8_WAIT_L(0); PG8_BAR; PG8_MMA(1, 0, At, B0); PG8_MMA(1, 1, At, B1); PG8_BAR; PG8_SCHED;
            PG8_LDB(B0, 1, 0); PG8_LDB(B1, 1, 1); PG8_SCHED; PG8_LDA(At, 1, 0); PG8_STAGE(PG8_SA(0, 1), a2 + hstep, voffA);
            PG8_WAIT_V(8); PG8_WAIT_L(0); PG8_BAR; PG8_MMA(0, 0, At, B0); PG8_MMA(0, 1, At, B1); PG8_BAR; PG8_SCHED;
            PG8_LDA(At, 1, 1); PG8_STAGE(PG8_SB(1, 0), b3, voffB); PG8_STAGE(PG8_SB(1, 1), b3 + hstep, voffB); PG8_STAGE(PG8_SA(1, 0), a3, voffA);
            PG8_WAIT_V(8); PG8_WAIT_L(0); PG8_BAR; PG8_MMA(1, 0, At, B0); PG8_MMA(1, 1, At, B1); PG8_BAR; PG8_SCHED;
            } else {
            PG8_LDB(B0, 0, 0); PG8_SCHED; PG8_LDA(At, 0, 0); PG8_STAGE(PG8_SA(1, 1), a1 + hstep, voffA);
            PG8_WAIT_L(8); PG8_BAR; PG8_WAIT_L(0); PG8_MMA(0, 0, At, B0); PG8_BAR; PG8_SCHED;
            PG8_LDB(B1, 0, 1); PG8_STAGE(PG8_SB(0, 0), b2, voffB);
            PG8_BAR; PG8_WAIT_L(0); PG8_MMA(0, 1, At, B1); PG8_BAR;
            PG8_LDA(At, 0, 1); PG8_STAGE(PG8_SA(0, 0), a2, voffA);
            PG8_BAR; PG8_WAIT_L(0); PG8_MMA(1, 0, At, B0); PG8_BAR; PG8_SCHED;
            PG8_STAGE(PG8_SB(0, 1), b2 + hstep, voffB);
            PG8_WAIT_V(6); PG8_BAR; PG8_MMA(1, 1, At, B1); PG8_BAR;
            PG8_LDB(B0, 1, 0); PG8_SCHED; PG8_LDA(At, 1, 0); PG8_STAGE(PG8_SA(0, 1), a2 + hstep, voffA);
            PG8_WAIT_L(8); PG8_BAR; PG8_WAIT_L(0); PG8_MMA(0, 0, At, B0); PG8_BAR; PG8_SCHED;
            PG8_LDB(B1, 1, 1); PG8_STAGE(PG8_SB(1, 0), b3, voffB);
            PG8_BAR; PG8_WAIT_L(0); PG8_MMA(0, 1, At, B1); PG8_BAR;
            PG8_LDA(At, 1, 1); PG8_STAGE(PG8_SA(1, 0), a3, voffA);
            PG8_BAR; PG8_WAIT_L(0); PG8_MMA(1, 0, At, B0); PG8_BAR; PG8_SCHED;
            PG8_STAGE(PG8_SB(1, 1), b3 + hstep, voffB);
            PG8_WAIT_V(6); PG8_BAR; PG8_MMA(1, 1, At, B1); PG8_BAR;
            }
        }
        if constexpr (ALIGN_EPI) { if (wr == 0) PG8_BAR; }
        if constexpr (!Epi::AFTER_DRAIN) { E(acc, cur, wr, wc, fr, fq); S.done(cur); }
        if (!has_next) break;
#pragma unroll
        for (int a = 0; a < 2; ++a)
#pragma unroll
            for (int b = 0; b < 2; ++b)
#pragma unroll
                for (int m = 0; m < 4; ++m)
#pragma unroll
                    for (int n = 0; n < 2; ++n) acc[a][b][m][n] = (f32x4){0.f, 0.f, 0.f, 0.f};
        cur = nxt; cA = nA; cB = nB; ++ui;
        if constexpr (ALIGN_EPI) { if (wr == 1) PG8_BAR; }
    }
    PG8_WAIT_V(0);
    if constexpr (!ALIGN_EPI) { if (wr == 0) PG8_BAR; }
    PG8_BAR;
#undef PG8_SA
#undef PG8_SB
#undef PG8_STAGE
#undef PG8_LDA
#undef PG8_LDB
#undef PG8_MMA
#undef PG8_WAIT_V
#undef PG8_WAIT_L
#undef PG8_BAR
#undef PG8_SCHED
}
}

namespace sa {
typedef LAS const char* lds_cptr;
typedef short v4i16_t __attribute__((ext_vector_type(4)));
__device__ __forceinline__ unsigned cvtpk(float lo, float hi) { unsigned r; asm("s_nop 0\n\tv_cvt_pk_bf16_f32 %0, %1, %2" : "=v"(r) : "v"(lo), "v"(hi)); return r; }
__device__ __forceinline__ void glds16(const void* g, unsigned lds_base) {
    unsigned sv; asm volatile("s_mov_b32 %0, m0\n\ts_mov_b32 m0, %2\n\ts_nop 0\n\tglobal_load_lds_dwordx4 %1, off\n\ts_mov_b32 m0, %0" : "=&s"(sv) : "v"(g), "s"(lds_base) : "memory"); }
__device__ __forceinline__ s16x4 vtr(lds_cptr p) { return __builtin_bit_cast(s16x4, __builtin_amdgcn_ds_read_tr16_b64_v4i16((LAS v4i16_t*)p)); }
__device__ __forceinline__ void glds16s(unsigned voff, const void* sbase, unsigned lds_base) {
    unsigned sv; asm volatile("s_mov_b32 %0, m0\n\ts_mov_b32 m0, %3\n\ts_nop 4\n\tglobal_load_lds_dwordx4 %1, %2\n\ts_mov_b32 m0, %0" : "=&s"(sv) : "v"(voff), "s"(sbase), "s"(lds_base) : "memory"); }
__device__ __forceinline__ float max3f(float a, float b, float c) { float r; asm("v_max3_f32 %0, %1, %2, %3" : "=v"(r) : "v"(a), "v"(b), "v"(c)); return r; }
__device__ __forceinline__ unsigned cvtpk_c(float lo, float hi) { typedef float f2 __attribute__((ext_vector_type(2))); typedef __bf16 b2 __attribute__((ext_vector_type(2))); f2 v = {lo, hi}; b2 b = __builtin_convertvector(v, b2); return __builtin_bit_cast(unsigned, b); }
#define SA_MFMA(a, b, c) __builtin_amdgcn_mfma_f32_32x32x16_bf16(a, b, c, 0, 0, 0)
#define SA_WAIT_BAR() asm volatile("s_waitcnt vmcnt(0) lgkmcnt(0)\n\ts_barrier" ::: "memory")
__device__ __forceinline__ float swap_sum(float v) { auto rr = __builtin_amdgcn_permlane32_swap(__float_as_uint(v), __float_as_uint(v), false, false); return __uint_as_float(rr[0]) + __uint_as_float(rr[1]); }
__device__ __forceinline__ float swap_max(float v) { auto rr = __builtin_amdgcn_permlane32_swap(__float_as_uint(v), __float_as_uint(v), false, false); return fmaxf(__uint_as_float(rr[0]), __uint_as_float(rr[1])); }
__device__ __forceinline__ float bf_lo(unsigned w) { return __uint_as_float(w << 16); }
__device__ __forceinline__ float bf_hi(unsigned w) { return __uint_as_float(w & 0xffff0000u); }

template <int NDB> struct Lay {
    static constexpr int NSLOT = 3, SLOT_K = 8192, SLOT_V = NDB * 4096, SLOT = SLOT_K + SLOT_V;
    static constexpr int WSF = NSLOT * SLOT, TAB = WSF + 2048, STG = TAB + 1280, STG_W = 8192, END = STG + 8 * STG_W;
};
constexpr float THR = 8.0f;

template <int NDB, int MODE>
__device__ __forceinline__ void stream(LAS char* lds, const bf16_t* Qw, int pq, const bf16_t* Kh, int pk, const bf16_t* Vh, int pv, int t_lo, int t_hi, int w_lo, int w_hi,
                                       int cw, int qi0, f32x16 (&o)[NDB], float& m, float& l) {
    typedef Lay<NDB> L;
    const int tid = threadIdx.x, lane = tid & 63, r32 = lane & 31, hi = lane >> 5; const int wid = __builtin_amdgcn_readfirstlane(tid >> 6);
    const unsigned lds0 = (unsigned)(size_t)lds;
    LAS float* wsf = (LAS float*)(lds + L::WSF) + wid * 64;
    const LAS float* tab = (const LAS float*)(lds + L::TAB);
    const bf16_t* ksrc = Kh + (size_t)lane * pk + wid * 8;
    auto issue = [&](int t, int slot) {
        glds16(ksrc + (size_t)t * 64 * pk, (unsigned)__builtin_amdgcn_readfirstlane(lds0 + slot * L::SLOT + wid * 1024));
#pragma unroll
        for (int j = 0; j < NDB / 2; ++j) { const int pc = wid + 8 * j;
            const bf16_t* vsrc = Vh + (size_t)(t * 64 + 16 * (pc & 3) + (lane >> 2)) * pv + (pc >> 2) * 32 + (lane & 3) * 8;
            glds16(vsrc, (unsigned)__builtin_amdgcn_readfirstlane(lds0 + slot * L::SLOT + L::SLOT_K + pc * 1024)); }
    };
    bf16x8 qr[4];
#pragma unroll
    for (int d0 = 0; d0 < 4; ++d0) qr[d0] = *(const bf16x8*)(Qw + (size_t)r32 * pq + d0 * 16 + hi * 8);
    issue(t_lo, 0);
    if (t_lo + 1 < t_hi) issue(t_lo + 1, 1);
#pragma unroll
    for (int d0 = 0; d0 < NDB; ++d0) o[d0] = f32x16{};
    m = 0.f; l = 0.f;
    f32x16 negm = f32x16{};
    if (t_lo + 1 < t_hi) { if (NDB == 4) asm volatile("s_waitcnt vmcnt(3) lgkmcnt(0)\n\ts_barrier" ::: "memory"); else asm volatile("s_waitcnt vmcnt(2) lgkmcnt(0)\n\ts_barrier" ::: "memory"); }
    else SA_WAIT_BAR();
    int cur = 0;
    for (int t = t_lo; t < t_hi; ++t) {
        const int nx2 = cur == 0 ? 2 : cur - 1;
        const bool more = t + 2 < t_hi;
        if (more) issue(t + 2, nx2);
        if (t >= w_lo && t <= w_hi) {
            const lds_cptr kb = (lds_cptr)lds + cur * L::SLOT + hi * 1024 + r32 * 16;
            f32x16 p0, p1;
#pragma unroll
            for (int d0 = 0; d0 < 4; ++d0) {
                const bf16x8 b0 = *(const LAS bf16x8*)(kb + d0 * 2048), b1 = *(const LAS bf16x8*)(kb + d0 * 2048 + 512);
                if (d0 == 0) { p0 = SA_MFMA(b0, qr[0], negm); p1 = SA_MFMA(b1, qr[0], negm); }
                else { p0 = SA_MFMA(b0, qr[d0], p0); p1 = SA_MFMA(b1, qr[d0], p1); }
            }
            if (MODE == 1) {
                const int dist = cw - t;
                if (dist >= 3) { const float cb = tab[256];
#pragma unroll
                    for (int r = 0; r < 16; ++r) { p0[r] += cb; p1[r] += cb; } }
                else { const int ib = dist * 64 + qi0 + r32 + 128 - 4 * hi;
#pragma unroll
                    for (int r = 0; r < 16; ++r) { const int k = (r & 3) + 8 * (r >> 2); int i0 = ib - k, i1 = ib - k - 32; i0 = i0 > 256 ? 256 : i0; i1 = i1 > 256 ? 256 : i1; p0[r] += tab[i0]; p1[r] += tab[i1]; } }
            }
            float rm = fmaxf(p0[0], p1[0]);
#pragma unroll
            for (int r = 1; r < 16; ++r) rm = fmaxf(rm, fmaxf(p0[r], p1[r]));
            rm = swap_max(rm);
            const bool first = (t == w_lo);
            if (first || __any(rm > THR)) {
                const float dl = first ? rm : fmaxf(rm, 0.f), al = first ? 1.f : __builtin_amdgcn_exp2f(-dl); l *= al; m += dl;
#pragma unroll
                for (int r = 0; r < 16; ++r) { p0[r] -= dl; p1[r] -= dl; negm[r] = -m; }
                if (hi == 0) wsf[r32] = al;
#pragma unroll
                for (int g = 0; g < 4; ++g) { const f32x4 a4 = *(const LAS f32x4*)(wsf + 8 * g + 4 * hi);
#pragma unroll
                    for (int d0 = 0; d0 < NDB; ++d0)
#pragma unroll
                        for (int j = 0; j < 4; ++j) o[d0][4 * g + j] *= a4[j]; }
            }
            float sum = 0.f;
#pragma unroll
            for (int r = 0; r < 16; ++r) { p0[r] = __builtin_amdgcn_exp2f(p0[r]); p1[r] = __builtin_amdgcn_exp2f(p1[r]); sum += p0[r] + p1[r]; }
            l += sum;
            u32x4 pw[4];
#pragma unroll
            for (int j = 0; j < 4; ++j) { pw[0][j] = cvtpk(p0[2 * j], p0[2 * j + 1]); pw[1][j] = cvtpk(p0[8 + 2 * j], p0[9 + 2 * j]); pw[2][j] = cvtpk(p1[2 * j], p1[2 * j + 1]); pw[3][j] = cvtpk(p1[8 + 2 * j], p1[9 + 2 * j]); }
            const lds_cptr vp = (lds_cptr)lds + cur * L::SLOT + L::SLOT_K + ((lane >> 4) & 1) * 32 + (lane & 3) * 8 + (4 * hi + ((lane & 15) >> 2)) * 64;
#pragma unroll
            for (int d0 = 0; d0 < NDB; ++d0) {
#pragma unroll
                for (int ks = 0; ks < 4; ++ks) {
                    const s16x4 lo = vtr(vp + d0 * 4096 + ks * 1024), hh = vtr(vp + d0 * 4096 + ks * 1024 + 512);
                    const bf16x8 vf = (bf16x8){lo[0], lo[1], lo[2], lo[3], hh[0], hh[1], hh[2], hh[3]};
                    o[d0] = SA_MFMA(__builtin_bit_cast(bf16x8, pw[ks]), vf, o[d0]);
                }
            }
        }
        if (more) { if (NDB == 4) asm volatile("s_waitcnt vmcnt(3) lgkmcnt(0)\n\ts_barrier" ::: "memory"); else asm volatile("s_waitcnt vmcnt(2) lgkmcnt(0)\n\ts_barrier" ::: "memory"); }
        else SA_WAIT_BAR();
        cur = cur == 2 ? 0 : cur + 1;
    }
}

template <int NDB> struct PPIssue {
    typedef Lay<NDB> L;
    unsigned lds0, kvoff, vvoff[NDB / 2]; int wid, pk, pv, T; const bf16_t* Kh; const bf16_t* Vh;
    __device__ __forceinline__ void init(LAS char* lds, const bf16_t* Kh_, int pk_, const bf16_t* Vh_, int pv_, int T_) {
        const int tid = threadIdx.x, lane = tid & 63; wid = __builtin_amdgcn_readfirstlane(tid >> 6);
        lds0 = (unsigned)(size_t)lds; Kh = Kh_; Vh = Vh_; pk = pk_; pv = pv_; T = T_;
        kvoff = (unsigned)(((8 * wid + (lane >> 3)) * pk + (((lane & 7) ^ ((4 * wid + (lane >> 4)) & 7)) * 8)) * 2);
#pragma unroll
        for (int j = 0; j < NDB / 2; ++j) { const int pc = wid + 8 * j; vvoff[j] = (unsigned)(((16 * (pc & 3) + (lane >> 2)) * pv + (pc >> 2) * 32 + (lane & 3) * 8) * 2); }
    }
    __device__ __forceinline__ void issue(int gt, int slot) const {
        const int kt = gt < T ? gt : T - 1, vt = gt >= 1 ? gt - 1 : 0;
        glds16s(kvoff, Kh + (size_t)kt * 64 * pk, (unsigned)__builtin_amdgcn_readfirstlane(lds0 + slot * L::SLOT + wid * 1024));
#pragma unroll
        for (int j = 0; j < NDB / 2; ++j) { const int pc = wid + 8 * j;
            glds16s(vvoff[j], Vh + (size_t)vt * 64 * pv, (unsigned)__builtin_amdgcn_readfirstlane(lds0 + slot * L::SLOT + L::SLOT_K + pc * 1024)); }
    }
};
template <int NDB>
__device__ __forceinline__ void pp_prefetch(LAS char* lds, const bf16_t* Qw, int pq, const bf16_t* Kh, int pk, const bf16_t* Vh, int pv, int T, bf16x8 (&qr)[4]) {
    const int lane = threadIdx.x & 63, r32 = lane & 31, hi = lane >> 5;
    PPIssue<NDB> I; I.init(lds, Kh, pk, Vh, pv, T);
#pragma unroll
    for (int d0 = 0; d0 < 4; ++d0) qr[d0] = *(const bf16x8*)(Qw + (size_t)r32 * pq + d0 * 16 + hi * 8);
    I.issue(0, 0); I.issue(1, 1);
}
template <int NDB, bool NOREF, int MODE>
__device__ __forceinline__ void stream_pp(LAS char* lds, const bf16_t* Kh, int pk, const bf16_t* Vh, int pv, int T, int w_lo, int w_hi, int cwr, int qi0, const bf16x8 (&qr)[4],
                                          f32x16 (&o)[NDB], float& l, float& m) {
    typedef Lay<NDB> L;
    static_assert(NDB == 4 || NDB == 2, "a group is 1 K + NDB/2 V pieces per wave: the counted waits below leave exactly one group in flight");
    constexpr int NF = 8 + 4 * NDB;
    const LAS float* tab = (const LAS float*)(lds + L::TAB);
    const int tid = threadIdx.x, lane = tid & 63, r32 = lane & 31, hi = lane >> 5; const int wid = __builtin_amdgcn_readfirstlane(tid >> 6);
    const int role = wid >> 2;
    LAS float* wsf = (LAS float*)(lds + L::WSF) + wid * 64;
    PPIssue<NDB> I; I.init(lds, Kh, pk, Vh, pv, T);
    auto issue = [&](int gt, int slot) { I.issue(gt, slot); };
#pragma unroll
    for (int d0 = 0; d0 < NDB; ++d0) o[d0] = f32x16{};
    m = 0.f; l = 0.f;
    f32x16 p0 = f32x16{}, p1 = f32x16{};
    u32x4 pw[4] = {};
    constexpr int PP_D = 6; bf16x8 fr[PP_D];
#define PP_WAITN() do { if (NDB == 4) asm volatile("s_waitcnt vmcnt(3) lgkmcnt(0)\n\ts_barrier" ::: "memory"); else asm volatile("s_waitcnt vmcnt(2) lgkmcnt(0)\n\ts_barrier" ::: "memory"); } while (0)
    PP_WAITN();
    __builtin_amdgcn_sched_barrier(0);
    int slot_m = 0;
    int slot_i = 2;
    const int kx0 = r32 * 128 + ((hi ^ ((r32 >> 1) & 7)) * 16);
    const lds_cptr vp0 = (lds_cptr)lds + L::SLOT_K + ((lane >> 4) & 1) * 32 + (lane & 3) * 8 + (4 * hi + ((lane & 15) >> 2)) * 64;
#define PP_ISSUE(t) do { if ((t) + 2 <= T) { issue((t) + 2, slot_i); slot_i = slot_i == 2 ? 0 : slot_i + 1; } } while (0)
#define PP_BAR_EVEN() do { __builtin_amdgcn_sched_barrier(0); } while (0)
#define PP_BAR_ODD(t) do { __builtin_amdgcn_sched_barrier(0); if ((t) + 2 <= T) PP_WAITN(); else SA_WAIT_BAR(); \
        __builtin_amdgcn_sched_barrier(0); slot_m = slot_m == 2 ? 0 : slot_m + 1; } while (0)
#define PP_SB() __builtin_amdgcn_sched_barrier(0)
#define PP_FRD(i) do { if ((i) < 8) { const int d0_ = (i) >> 1; fr[(i) % PP_D] = *(const LAS bf16x8*)((lds_cptr)lds + slot_m * L::SLOT + (kx0 ^ (d0_ * 32)) + ((i) & 1) * 4096); } \
        else { const lds_cptr vp_ = vp0 + slot_m * L::SLOT + (((i) - 8) >> 2) * 4096 + (((i) - 8) & 3) * 1024; const s16x4 lo_ = vtr(vp_), hh_ = vtr(vp_ + 512); \
               fr[(i) % PP_D] = (bf16x8){lo_[0], lo_[1], lo_[2], lo_[3], hh_[0], hh_[1], hh_[2], hh_[3]}; } } while (0)
#define PP_FMA(i) do { if ((i) < 8) { if ((i) & 1) p1 = SA_MFMA(fr[(i) % PP_D], qr[(i) >> 1], p1); else p0 = SA_MFMA(fr[(i) % PP_D], qr[(i) >> 1], p0); } \
        else o[((i) - 8) >> 2] = SA_MFMA(__builtin_bit_cast(bf16x8, pw[((i) - 8) & 3]), fr[(i) % PP_D], o[((i) - 8) >> 2]); } while (0)
#define PP_PIPE(lo, hi) do { \
        _Pragma("unroll") for (int i_ = (lo); i_ < (lo) + PP_D && i_ < (hi); ++i_) PP_FRD(i_); \
        if ((lo) < 8) { if (NOREF) { p0 = f32x16{}; p1 = f32x16{}; } else { _Pragma("unroll") for (int r = 0; r < 16; ++r) { p0[r] = -m; p1[r] = -m; } } } \
        PP_SB(); \
        _Pragma("unroll") for (int i_ = (lo); i_ < (hi); ++i_) { PP_FMA(i_); if (i_ + PP_D < (hi)) PP_FRD(i_ + PP_D); PP_SB(); } \
        if ((lo) < 8) asm volatile("" : "+v"(p0), "+v"(p1)); } while (0)
#define PP_QK() PP_PIPE(0, 8)
#define PP_PV() PP_PIPE(8, NF)
#define PP_QKPV() PP_PIPE(0, NF)
#define PP_SOFT(first, ts) do { \
        if (MODE == 1) { const int dist_ = cwr - (ts); \
            if (dist_ < 3) {     \
                const LAS float* fb_ = tab + (dist_ * 64 + qi0 + r32 + 128 - 4 * hi - 59);     \
                _Pragma("unroll") for (int r = 0; r < 16; ++r) { const int k_ = (r & 3) + 8 * (r >> 2); p0[r] += fb_[59 - k_]; p1[r] += fb_[27 - k_]; } } } \
        if (!NOREF) { \
        asm volatile("s_nop 15\n\ts_nop 3" : "+v"(p0), "+v"(p1));     \
        float rm = max3f(p0[0], p1[0], p0[1]), rm2 = max3f(p1[1], p0[2], p1[2]); \
        _Pragma("unroll") for (int r = 3; r < 15; r += 2) { rm = max3f(rm, p0[r], p1[r]); rm2 = max3f(rm2, p0[r + 1], p1[r + 1]); } \
        rm = max3f(rm, p0[15], p1[15]); rm = fmaxf(rm, rm2); \
        rm = swap_max(rm); \
        if ((first) || __any(rm > THR)) { \
            const float dl = (first) ? rm : fmaxf(rm, 0.f), al = (first) ? 1.f : __builtin_amdgcn_exp2f(-dl); l *= al; m += dl; \
            _Pragma("unroll") for (int r = 0; r < 16; ++r) { p0[r] -= dl; p1[r] -= dl; } \
            if (hi == 0) wsf[r32] = al; \
            _Pragma("unroll") for (int gq = 0; gq < 4; ++gq) { const f32x4 a4 = *(const LAS f32x4*)(wsf + 8 * gq + 4 * hi); \
                _Pragma("unroll") for (int d0 = 0; d0 < NDB; ++d0) _Pragma("unroll") for (int j = 0; j < 4; ++j) o[d0][4 * gq + j] *= a4[j]; } } } \
        float sum = 0.f; \
        _Pragma("unroll") for (int r = 0; r < 16; ++r) { p0[r] = __builtin_amdgcn_exp2f(p0[r]); p1[r] = __builtin_amdgcn_exp2f(p1[r]); sum += p0[r] + p1[r]; } \
        l += sum; \
        _Pragma("unroll") for (int j = 0; j < 4; ++j) { pw[0][j] = cvtpk_c(p0[2 * j], p0[2 * j + 1]); pw[1][j] = cvtpk_c(p0[8 + 2 * j], p0[9 + 2 * j]); pw[2][j] = cvtpk_c(p1[2 * j], p1[2 * j + 1]); pw[3][j] = cvtpk_c(p1[8 + 2 * j], p1[9 + 2 * j]); } \
        asm volatile("" : "+v"(pw[0]), "+v"(pw[1]), "+v"(pw[2]), "+v"(pw[3]), "+v"(l));     \
        } while (0)
    if (role == 0) {
#pragma clang loop unroll(disable)
        for (int t = 0; t < w_lo; ++t) { PP_ISSUE(t); PP_BAR_ODD(t); }
        { const int t = w_lo; PP_QK(); PP_BAR_EVEN(); PP_ISSUE(t); PP_SOFT(true, t); PP_BAR_ODD(t); }
#pragma clang loop unroll(disable)
        for (int t = w_lo + 1; t <= w_hi; ++t) {
            PP_QKPV(); PP_BAR_EVEN(); PP_ISSUE(t); PP_SOFT(false, t); PP_BAR_ODD(t);
        }
        { const int t = w_hi + 1; PP_PV(); PP_BAR_EVEN(); PP_ISSUE(t); PP_BAR_ODD(t); }
#pragma clang loop unroll(disable)
        for (int t = w_hi + 2; t <= T; ++t) { PP_ISSUE(t); PP_BAR_EVEN(); PP_BAR_ODD(t); }
    } else {
#pragma clang loop unroll(disable)
        for (int t = 0; t < w_lo; ++t) { PP_ISSUE(t); PP_BAR_ODD(t); }
        { const int t = w_lo; PP_ISSUE(t); PP_BAR_EVEN(); PP_QK(); PP_BAR_ODD(t); }
#pragma clang loop unroll(disable)
        for (int t = w_lo + 1; t <= w_hi; ++t) {
            PP_ISSUE(t); PP_SOFT(t - 1 == w_lo, t - 1); PP_BAR_EVEN(); PP_QKPV(); PP_BAR_ODD(t);
        }
        { const int t = w_hi + 1; PP_ISSUE(t); PP_SOFT(t - 1 == w_lo, t - 1); PP_BAR_EVEN(); PP_PV(); PP_BAR_ODD(t); }
#pragma clang loop unroll(disable)
        for (int t = w_hi + 2; t <= T; ++t) { PP_ISSUE(t); PP_BAR_EVEN(); PP_BAR_ODD(t); }
    }
#undef PP_ISSUE
#undef PP_WAITN
#undef PP_BAR_EVEN
#undef PP_BAR_ODD
#undef PP_QK
#undef PP_SB
#undef PP_QKPV
#undef PP_FRD
#undef PP_FMA
#undef PP_PIPE
#undef PP_PV
#undef PP_SOFT
}
}

#define XB_TMO      128
#define XB_XCNT(j)  (256  + 64 * (j))
#define XB_XSUB(j)  (1280 + 64 * (j))
#define XB_XGEN(j)  (2304 + 64 * (j))
#define XB_TOP      3328
#define XB_TOPGEN   3392
#define XCD_BAR_WORDS 3456
#define XB_SPIN_CAP (1u << 18)
__device__ __forceinline__ unsigned xb_ld(unsigned* p)              { return __hip_atomic_load(p, __ATOMIC_RELAXED, __HIP_MEMORY_SCOPE_AGENT); }
__device__ __forceinline__ unsigned xb_add(unsigned* p, unsigned v) { return __hip_atomic_fetch_add(p, v, __ATOMIC_RELAXED, __HIP_MEMORY_SCOPE_AGENT); }
__device__ __forceinline__ unsigned xb_xcc_id() { return (unsigned)__builtin_amdgcn_s_getreg((3 << 11) | 20) & 0xFu; }
#define XB_SPIN(cond, bar) do { unsigned _sp = 0; while (cond) { __builtin_amdgcn_s_sleep(1); \
    if ((++_sp & 255u) == 0u) { if (xb_ld(&(bar)[XB_TMO])) break; if (_sp > XB_SPIN_CAP) { atomicAdd(&(bar)[XB_TMO], 1u); break; } } } } while (0)
struct XcdBarrier { unsigned* bar; unsigned x; volatile LAS unsigned* st; };
__device__ __forceinline__ XcdBarrier xcd_barrier_post(unsigned* bar, volatile LAS unsigned* st) {
    XcdBarrier b; b.bar = bar; b.x = xb_xcc_id(); b.st = st;
    if (threadIdx.x == 0) (void)xb_add(&bar[XB_XCNT(b.x)], 1u);
    return b;
}
__device__ __forceinline__ void xcd_barrier_complete(unsigned* bar, unsigned x, unsigned& nloc, unsigned& nx) {
    const unsigned G = gridDim.x * gridDim.y * gridDim.z;
    unsigned sum, cnt, mine, sp = 0u;
    for (;;) {
        sum = 0u; cnt = 0u; mine = 0u;
#pragma unroll
        for (unsigned j = 0; j < 16; ++j) { const unsigned c = xb_ld(&bar[XB_XCNT(j)]); sum += c; cnt += (c > 0u) ? 1u : 0u; mine = (j == x) ? c : mine; }
        if (sum == G) break;
        __builtin_amdgcn_s_sleep(1);
        if ((++sp & 255u) == 0u) { if (xb_ld(&bar[XB_TMO])) break; if (sp > XB_SPIN_CAP) { atomicAdd(&bar[XB_TMO], 1u); break; } }
    }
    nloc = mine > 0u ? mine : 1u; nx = cnt > 0u ? cnt : 1u;
}
__device__ __forceinline__ void xcd_barrier(const XcdBarrier& b) {
    asm volatile("s_waitcnt vmcnt(0)" ::: "memory");
    __syncthreads();
    if (threadIdx.x == 0) {
        unsigned* bar = b.bar;
        __builtin_amdgcn_s_waitcnt(0);
        unsigned nloc = b.st[0], nx = b.st[1];
        if (nloc == 0u) { xcd_barrier_complete(bar, b.x, nloc, nx); b.st[0] = nloc; b.st[1] = nx; }
        const unsigned old = xb_add(&bar[XB_XSUB(b.x)], 1u);
        const unsigned gen = old / nloc;
        if (old + 1u == (gen + 1u) * nloc) {
            __builtin_amdgcn_fence(__ATOMIC_RELEASE, "agent");
            asm volatile("s_waitcnt vmcnt(0)" ::: "memory");
            const unsigned og = xb_add(&bar[XB_TOP], 1u);
            const unsigned tg = og / nx;
            if (og + 1u == (tg + 1u) * nx) xb_add(&bar[XB_TOPGEN], 1u);
            else XB_SPIN(xb_ld(&bar[XB_TOPGEN]) == tg, bar);
            __builtin_amdgcn_fence(__ATOMIC_ACQUIRE, "agent");
            xb_add(&bar[XB_XGEN(b.x)], 1u);
            asm volatile("s_waitcnt vmcnt(0)" ::: "memory");
        } else {
            XB_SPIN(xb_ld(&bar[XB_XGEN(b.x)]) == gen, bar);
            __builtin_amdgcn_fence(__ATOMIC_ACQUIRE, "agent");
            asm volatile("s_waitcnt vmcnt(0)" ::: "memory");
        }
    }
    __syncthreads();
}

constexpr int NWAVES = 8;
constexpr int LDS_BYTES = 147456;
constexpr int N_PHASES = 7;
static_assert(sa::Lay<4>::END <= LDS_BYTES && sa::Lay<2>::END <= LDS_BYTES && pg8::STAGE_BYTES <= LDS_BYTES, "LDS layouts fit the dynamic LDS array");

struct Args { const float* in[20]; float* out; unsigned char* ws; int ph_lo, ph_hi; };

__device__ __forceinline__ float wave_sum(float v) {
#pragma unroll
    for (int o = 1; o < 64; o <<= 1) v += __shfl_xor(v, o);
    return v;
}
__device__ __forceinline__ unsigned f2bf(float f) { unsigned u = __builtin_bit_cast(unsigned, f); return (u + 0x7fffu + ((u >> 16) & 1u)) >> 16; }
__device__ __forceinline__ unsigned pk2(float lo, float hi) { return f2bf(lo) | (f2bf(hi) << 16); }

__device__ __forceinline__ void transpose_item(const float* W, int K, int N, bf16_t* WT, bool permute, const float* gk, LAS float* scr, int item, int lane) {
    const int nblk = N / 32, kb = item / nblk, nb = item % nblk, k0 = 64 * kb, n0 = 32 * nb;
    f32x4 wv[8];
#pragma unroll
    for (int i = 0; i < 8; ++i) wv[i] = *(const f32x4*)(W + (size_t)(k0 + 8 * i + (lane >> 3)) * N + n0 + 4 * (lane & 7));
#pragma unroll
    for (int i = 0; i < 8; ++i) { const int kk = 8 * i + (lane >> 3); const float gsc = gk ? gk[k0 + kk] : 1.0f;
#pragma unroll
        for (int j = 0; j < 4; ++j) scr[kk * 33 + 4 * (lane & 7) + j] = wv[i][j] * gsc; }
    asm volatile("s_waitcnt lgkmcnt(0)" ::: "memory");
    int prow0 = n0;
    if (permute) { const int gl = (n0 & 255) >> 5, wc = gl >> 1, bj = gl & 1; prow0 = (n0 & ~255) + (4 * bj + wc) * 32; }
    const int c = lane & 7;
#pragma unroll
    for (int j = 0; j < 4; ++j) { const int n = (lane >> 3) + 8 * j; const LAS float* s = scr + (8 * c) * 33 + n;
        u32x4 o; o.x = pk2(s[0 * 33], s[1 * 33]); o.y = pk2(s[2 * 33], s[3 * 33]); o.z = pk2(s[4 * 33], s[5 * 33]); o.w = pk2(s[6 * 33], s[7 * 33]);
        *(u32x4*)(WT + (size_t)(prow0 + n) * K + k0 + 8 * c) = o; }
    asm volatile("s_waitcnt lgkmcnt(0)" ::: "memory");
}

__global__ void __launch_bounds__(NWAVES * 64, 2) fwd_kernel(Args args) {
    extern __shared__ __attribute__((aligned(16))) unsigned char lds_raw[];
    LAS unsigned char* lds = (LAS unsigned char*)lds_raw;
    const int tid = threadIdx.x, lane = tid & 63, wid = __builtin_amdgcn_readfirstlane(tid >> 6);
    const int G = gridDim.x, bx = blockIdx.x;
    const int vcu = (G % 8 == 0) ? (bx % 8) * (G / 8) + bx / 8 : bx;
    const int r32 = lane & 31, hi = lane >> 5;
    unsigned char* ws = args.ws;
    const float* x = args.in[0];
    float* out = args.out;
    bf16_t* W0T = (bf16_t*)(ws + WS_W0T); bf16_t* WO0T = (bf16_t*)(ws + WS_WO0T); bf16_t* W1T = (bf16_t*)(ws + WS_W1T); bf16_t* WO1T = (bf16_t*)(ws + WS_WO1T);
    float* ROPE = (float*)(ws + WS_ROPE); float* SS = (float*)(ws + WS_SS);
    bf16_t* XN = (bf16_t*)(ws + WS_XN); bf16_t* MIX = (bf16_t*)(ws + WS_MIX); bf16_t* PROJ = (bf16_t*)(ws + WS_PROJ);
    const int lo = args.ph_lo, hi_ph = args.ph_hi;
#define IN(k) (lo <= (k) && (k) < hi_ph)
    volatile LAS unsigned* xb_st = (volatile LAS unsigned*)(lds + LDS_BYTES - 64);
    if (tid < 2) xb_st[tid] = 0u;
    __syncthreads();
    XcdBarrier xbar; xbar.bar = (unsigned*)ws; xbar.x = 0; xbar.st = xb_st;
    if (hi_ph - lo > 1) xbar = xcd_barrier_post((unsigned*)ws, xb_st);
#define SEAM(k) do { if (IN(k) && IN((k) + 1)) { xcd_barrier(xbar); } } while (0)

    if (IN(0)) {
        LAS float* scr = (LAS float*)(lds + wid * 16384);
        const int gw = vcu * NWAVES + wid, NGW = G * NWAVES;
        constexpr int I_0 = (DM / 64) * (N0 / 32), I_O = (DM / 64) * (DM / 32), I_1 = (DM / 64) * (N1 / 32);
        constexpr int NITEMS = I_0 + I_O + I_1 + I_O;
        for (int it = gw; it < NITEMS; it += NGW) {
            int r = it;
            if (r < I_0) { transpose_item(args.in[2], DM, N0, W0T, true, nullptr, scr, r, lane); continue; } r -= I_0;
            if (r < I_O) { transpose_item(args.in[3], DM, DM, WO0T, false, nullptr, scr, r, lane); continue; } r -= I_O;
            if (r < I_1) { transpose_item(args.in[11], DM, N1, W1T, true, args.in[10], scr, r, lane); continue; } r -= I_1;
            transpose_item(args.in[12], DM, DM, WO1T, false, nullptr, scr, r, lane);
        }
        for (int e = (vcu * NWAVES * 64) + tid; e < SEQ * 32; e += G * NWAVES * 64) {
            const int pos = e >> 5, i = e & 31;
            const float inv = 1.0f / powf(10000.0f, (float)(2 * i) / 64.0f);
            const float ang = (float)pos * inv;
            ROPE[e] = cosf(ang); ROPE[SEQ * 32 + e] = sinf(ang);
        }
        const float* gn = args.in[1];
        for (int mrow = gw; mrow < M_ROWS; mrow += NGW) {
            const f32x4* xr = (const f32x4*)(x + (size_t)mrow * DM) + lane;
            f32x4 v[4]; float s = 0.f;
#pragma unroll
            for (int j = 0; j < 4; ++j) { v[j] = xr[64 * j]; s += (v[j][0] * v[j][0] + v[j][1] * v[j][1]) + (v[j][2] * v[j][2] + v[j][3] * v[j][3]); }
            const float rstd = 1.0f / sqrtf(wave_sum(s) * (1.0f / DM) + EPS);
            unsigned long long* o8 = (unsigned long long*)(XN + (size_t)mrow * DM) + lane;
#pragma unroll
            for (int j = 0; j < 4; ++j) { const f32x4 g4 = *((const f32x4*)gn + lane + 64 * j);
                o8[64 * j] = (unsigned long long)pk2(v[j][0] * rstd * g4[0], v[j][1] * rstd * g4[1]) | ((unsigned long long)pk2(v[j][2] * rstd * g4[2], v[j][3] * rstd * g4[3]) << 32); }
        }
        __syncthreads();
    }
    SEAM(0);

    if (IN(1)) {
        pg8::Gemm g{XN, W0T, M_ROWS, N0, DM}; pg8::StaticOrder S; S.init(M_ROWS, N0, G, bx);
        pg8::EpiProj E{PROJ, N0, 0, args.in[4], args.in[5], args.in[7], args.in[8], ROPE, nullptr};
        pg8::gemm_phase<pg8::EpiProj, pg8::StaticOrder, true, true>(lds, g, S, E);
    }
    SEAM(1);

    if (IN(2)) {
        typedef sa::Lay<2> L;
        LAS char* al = (LAS char*)lds;
        LAS float* wsf = (LAS float*)(al + L::WSF) + wid * 64;
        LAS float* stg = (LAS float*)(al + L::STG + wid * L::STG_W);
        bool norefA, norefB;
        { float gqa = fabsf(args.in[4][lane]), gka = fabsf(args.in[5][lane]), gqb = fabsf(args.in[7][lane]), gkb = fabsf(args.in[8][lane]), bm = 0.f;
          { float bv[33];
#pragma unroll
            for (int k_ = 0; k_ < 33; ++k_) { const int i_ = lane + 64 * k_; bv[k_] = args.in[9][i_ < 8 * 257 ? i_ : 8 * 257 - 1]; }
#pragma unroll
            for (int k_ = 0; k_ < 33; ++k_) bm = fmaxf(bm, fabsf(bv[k_])); }
#pragma unroll
          for (int o_ = 1; o_ < 64; o_ <<= 1) { gqa = fmaxf(gqa, __shfl_xor(gqa, o_)); gka = fmaxf(gka, __shfl_xor(gka, o_)); gqb = fmaxf(gqb, __shfl_xor(gqb, o_)); gkb = fmaxf(gkb, __shfl_xor(gkb, o_)); bm = fmaxf(bm, __shfl_xor(bm, o_)); }
          norefA = __builtin_amdgcn_readfirstlane((64.0f * C2 * gqa * gka <= 60.0f) ? 1 : 0) != 0;
          norefB = __builtin_amdgcn_readfirstlane((64.0f * C2 * gqb * gkb + 2.0f * LOG2E * bm <= 60.0f) ? 1 : 0) != 0; }
        auto gate_ld = [&](u32x4 (&gt)[4], size_t qrow0, int gcol) {
#pragma unroll
            for (int i = 0; i < 4; ++i) { const int row = i * 8 + (lane >> 3), c8 = lane & 7; gt[i] = *(const u32x4*)(PROJ + (qrow0 + row) * N0 + gcol + c8 * 8); } };
        auto epi_ab = [&](const f32x16 (&o)[2], float scl, size_t qrow0, const u32x4 (&gtv)[4], int mcol) {
            if (hi == 0) wsf[32 + r32] = scl;
#pragma unroll
            for (int g = 0; g < 4; ++g) { const f32x4 s4 = *(const LAS f32x4*)(wsf + 32 + 8 * g + 4 * hi);
#pragma unroll
                for (int d0 = 0; d0 < 2; ++d0)
#pragma unroll
                    for (int j = 0; j < 4; ++j) stg[(8 * g + 4 * hi + j) * 64 + d0 * 32 + r32] = o[d0][4 * g + j] * s4[j]; }
#pragma unroll
            for (int i = 0; i < 4; ++i) { const int row = i * 8 + (lane >> 3), c8 = lane & 7;
                const f32x4 a = *(const LAS f32x4*)(stg + row * 64 + c8 * 8), bb = *(const LAS f32x4*)(stg + row * 64 + c8 * 8 + 4);
                const u32x4 gt = gtv[i];
                u32x4 w; w.x = sa::cvtpk(a[0] * sa::bf_lo(gt.x), a[1] * sa::bf_hi(gt.x)); w.y = sa::cvtpk(a[2] * sa::bf_lo(gt.y), a[3] * sa::bf_hi(gt.y));
                w.z = sa::cvtpk(bb[0] * sa::bf_lo(gt.z), bb[1] * sa::bf_hi(gt.z)); w.w = sa::cvtpk(bb[2] * sa::bf_lo(gt.w), bb[3] * sa::bf_hi(gt.w));
                *(u32x4*)(MIX + (qrow0 + row) * DM + mcol + c8 * 8) = w; }
        };
        bf16x8 qr[4];
        struct GA { int c, b, kvh, hq, t_lo; size_t qrow0; const bf16_t *Qw, *Kh, *Vh; };
        auto geom_a = [&](int id) { GA g; g.c = id & 127; const int bk = id >> 7; g.b = bk >> 1; g.kvh = bk & 1; g.hq = g.kvh * 4 + (wid >> 1);
            g.qrow0 = (size_t)g.b * SEQ + g.c * 64 + (wid & 1) * 32; g.t_lo = g.c >= 2 ? g.c - 2 : 0;
            g.Qw = PROJ + g.qrow0 * N0 + C_AQ + g.hq * 64; g.Kh = PROJ + (size_t)g.b * SEQ * N0 + C_AK + g.kvh * 64; g.Vh = PROJ + (size_t)g.b * SEQ * N0 + C_AV + g.kvh * 64; return g; };
        if (norefA && vcu < BATCH * 2 * 128) { const GA g = geom_a(vcu); sa::pp_prefetch<2>(al, g.Qw, N0, g.Kh + (size_t)g.t_lo * 64 * N0, N0, g.Vh + (size_t)g.t_lo * 64 * N0, N0, g.c + 1 - g.t_lo, qr); }
        for (int id = vcu; id < BATCH * 2 * 128; id += G) {
            const GA g = geom_a(id);
            f32x16 o[2]; float m, l;
            u32x4 gtv[4]; gate_ld(gtv, g.qrow0, C_AG + g.hq * 64);
            if (norefA) {
                sa::stream_pp<2, true, 0>(al, g.Kh + (size_t)g.t_lo * 64 * N0, N0, g.Vh + (size_t)g.t_lo * 64 * N0, N0, g.c + 1 - g.t_lo, 0, g.c - g.t_lo, 0, 0, qr, o, l, m);
                if (id + G < BATCH * 2 * 128) { const GA n = geom_a(id + G);
                    sa::pp_prefetch<2>(al, n.Qw, N0, n.Kh + (size_t)n.t_lo * 64 * N0, N0, n.Vh + (size_t)n.t_lo * 64 * N0, N0, n.c + 1 - n.t_lo, qr); }
            } else sa::stream<2, 0>(al, g.Qw, N0, g.Kh, N0, g.Vh, N0, g.t_lo, g.c + 1, g.t_lo, g.c, 0, 0, o, m, l);
            float lt = sa::swap_sum(l);
            const float s2 = args.in[6][g.hq] * LOG2E, mf = fmaxf(m, s2), e1 = __builtin_amdgcn_exp2f(m - mf);
            lt = lt * e1 + __builtin_amdgcn_exp2f(s2 - mf);
            epi_ab(o, e1 / lt, g.qrow0, gtv, g.hq * 64);
        }
        struct GB { int b, h, c0, cw, t_lo, w_lo; size_t qrow0; const bf16_t *Qw, *Kh, *Vh; };
        auto geom_b = [&](int id) { GB g; const int cg4 = id & 31, bh = id >> 5; g.b = bh >> 3; g.h = bh & 7; g.c0 = cg4 * 4; g.cw = g.c0 + (wid >> 1);
            g.qrow0 = (size_t)g.b * SEQ + g.cw * 64 + (wid & 1) * 32; g.t_lo = g.c0 >= 8 ? g.c0 - 8 : 0; g.w_lo = g.cw >= 8 ? g.cw - 8 : 0;
            g.Qw = PROJ + g.qrow0 * N0 + C_BQ + g.h * 64; g.Kh = PROJ + (size_t)g.b * SEQ * N0 + C_BK + g.h * 64; g.Vh = PROJ + (size_t)g.b * SEQ * N0 + C_BV + g.h * 64; return g; };
        LAS float* tabw = (LAS float*)(al + L::TAB);
        auto fill_tab = [&](int h) { if (tid < 320) tabw[tid] = (args.in[9][h * 257 + (tid < 256 ? tid : 256)] - args.in[9][h * 257 + 256]) * LOG2E; };
        if (norefB && vcu < BATCH * 8 * 32) { const GB g = geom_b(vcu); fill_tab(g.h);
            sa::pp_prefetch<2>(al, g.Qw, N0, g.Kh + (size_t)g.t_lo * 64 * N0, N0, g.Vh + (size_t)g.t_lo * 64 * N0, N0, g.c0 + 4 - g.t_lo, qr); }
        for (int id = vcu; id < BATCH * 8 * 32; id += G) {
            const GB g = geom_b(id);
            f32x16 o[2]; float m, l;
            u32x4 gtv[4]; gate_ld(gtv, g.qrow0, C_BG + g.h * 64);
            if (norefB) {
                sa::stream_pp<2, true, 1>(al, g.Kh + (size_t)g.t_lo * 64 * N0, N0, g.Vh + (size_t)g.t_lo * 64 * N0, N0, g.c0 + 4 - g.t_lo, g.w_lo - g.t_lo, g.cw - g.t_lo, g.cw - g.t_lo, (wid & 1) * 32, qr, o, l, m);
                if (id + G < BATCH * 8 * 32) { const GB n = geom_b(id + G); fill_tab(n.h);
                    sa::pp_prefetch<2>(al, n.Qw, N0, n.Kh + (size_t)n.t_lo * 64 * N0, N0, n.Vh + (size_t)n.t_lo * 64 * N0, N0, n.c0 + 4 - n.t_lo, qr); }
            } else { fill_tab(g.h); sa::stream<2, 1>(al, g.Qw, N0, g.Kh, N0, g.Vh, N0, g.t_lo, g.c0 + 4, g.w_lo, g.cw, g.cw, (wid & 1) * 32, o, m, l); }
            epi_ab(o, 1.0f / sa::swap_sum(l), g.qrow0, gtv, 512 + g.h * 64);
        }
        asm volatile("s_waitcnt vmcnt(0) lgkmcnt(0)" ::: "memory");
        __syncthreads();
    }
    SEAM(2);

    if (IN(3)) {
        pg8::Gemm g{MIX, WO0T, M_ROWS, DM, DM}; pg8::StaticOrder S; S.init(M_ROWS, DM, G, bx);
        pg8::EpiRes E{x, nullptr, nullptr, XN, SS};
        pg8::gemm_phase<pg8::EpiRes, pg8::StaticOrder, true, true>(lds, g, S, E);
    }
    SEAM(3);

    if (IN(4)) {
        pg8::Gemm g{XN, W1T, M_ROWS, N1, DM}; pg8::StaticOrder S; S.init(M_ROWS, N1, G, bx);
        pg8::EpiProj E{PROJ, N1, 1, args.in[13], args.in[14], nullptr, nullptr, ROPE, SS};
        pg8::gemm_phase<pg8::EpiProj, pg8::StaticOrder, true, true>(lds, g, S, E);
    }
    SEAM(4);

    if (IN(5)) {
        typedef sa::Lay<4> L;
        LAS char* al = (LAS char*)lds;
        float lam;
        { const float a = args.in[15][lane] * args.in[16][lane], bq = args.in[17][lane] * args.in[18][lane];
          lam = __expf(wave_sum(a)) - __expf(wave_sum(bq)) + LAMBDA_INIT; }
        const float* subg = args.in[19];
        bool noref;
        { float gq = fabsf(args.in[13][lane]), gk = fabsf(args.in[14][lane]);
#pragma unroll
          for (int o_ = 1; o_ < 64; o_ <<= 1) { gq = fmaxf(gq, __shfl_xor(gq, o_)); gk = fmaxf(gk, __shfl_xor(gk, o_)); }
          noref = __builtin_amdgcn_readfirstlane((64.0f * C2 * gq * gk <= 60.0f) ? 1 : 0) != 0; }
        const bf16_t* Q1 = PROJ; const bf16_t* K1 = PROJ + (size_t)M_ROWS * 1024; const bf16_t* V1 = PROJ + (size_t)M_ROWS * 2048; const bf16_t* G1 = PROJ + (size_t)M_ROWS * 3072;
        struct GC { int b, h, qb, cw, T; size_t qrow0; const bf16_t *Qp, *Kp, *Vh; };
        auto geom_c = [&](int id, int pass) { GC g; const int i = id >> 8, v = id & 255, bh = v >> 3, s = v & 7; g.b = bh >> 3; g.h = bh & 7;
            g.qb = (i == 0) ? s : (i == 1) ? 15 - s : (i == 2) ? 16 + s : 31 - s; g.cw = g.qb * 4 + (wid >> 1); g.T = g.qb * 4 + 4;
            g.qrow0 = (size_t)g.b * SEQ + g.qb * 256 + wid * 32; const int vh = 2 * g.h + 1 - pass;
            g.Qp = Q1 + ((size_t)(g.b * 16 + vh) * SEQ + g.qb * 256 + wid * 32) * 64; g.Kp = K1 + (size_t)(g.b * 16 + vh) * SEQ * 64; g.Vh = V1 + (size_t)(g.b * 8 + g.h) * SEQ * 128; return g; };
        bf16x8 qr[4];
        if (vcu < BATCH * 8 * 32) { const GC g = geom_c(vcu, 0); sa::pp_prefetch<4>(al, g.Qp, 64, g.Kp, 64, g.Vh, 128, g.T, qr); }
        for (int id = vcu; id < BATCH * 8 * 32; id += G) {
            const GC g0 = geom_c(id, 0);
            const int h = g0.h; const size_t qrow0 = g0.qrow0;
            f32x16 o[4]; float l, mref;
#pragma clang loop unroll(disable)
            for (int pass = 0; pass < 2; ++pass) {
                const GC g = geom_c(id, pass);
                if (noref) sa::stream_pp<4, true, 0>(al, g.Kp, 64, g.Vh, 128, g.T, 0, g.cw, 0, 0, qr, o, l, mref);
                else sa::stream_pp<4, false, 0>(al, g.Kp, 64, g.Vh, 128, g.T, 0, g.cw, 0, 0, qr, o, l, mref);
                if (pass == 0) { const GC n = geom_c(id, 1); sa::pp_prefetch<4>(al, n.Qp, 64, n.Kp, 64, n.Vh, 128, n.T, qr); }
                else if (id + G < BATCH * 8 * 32) { const GC n = geom_c(id + G, 0); sa::pp_prefetch<4>(al, n.Qp, 64, n.Kp, 64, n.Vh, 128, n.T, qr); }
                if (pass == 0) {
                    const float scl = 1.0f / sa::swap_sum(l);
                    int le = lane; asm volatile("" : "+v"(le));
                    const int r32e = le & 31, hie = le >> 5;
                    LAS float* wsfe = (LAS float*)(al + L::WSF) + wid * 64;
                    LAS unsigned* parke = (LAS unsigned*)(al + L::STG + wid * L::STG_W) + le;
                    if (hie == 0) wsfe[32 + r32e] = scl;
#pragma unroll
                    for (int g = 0; g < 4; ++g) { const f32x4 s4 = *(const LAS f32x4*)(wsfe + 32 + 8 * g + 4 * hie);
#pragma unroll
                        for (int d0 = 0; d0 < 4; ++d0) { parke[(d0 * 8 + 2 * g) * 64] = sa::cvtpk(o[d0][4 * g] * s4[0], o[d0][4 * g + 1] * s4[1]); parke[(d0 * 8 + 2 * g + 1) * 64] = sa::cvtpk(o[d0][4 * g + 2] * s4[2], o[d0][4 * g + 3] * s4[3]); } }
                }
            }
            int le = lane; asm volatile("" : "+v"(le));
            const int r32e = le & 31, hie = le >> 5;
            LAS float* wsfe = (LAS float*)(al + L::WSF) + wid * 64;
            LAS float* stge = (LAS float*)(al + L::STG + wid * L::STG_W);
            const LAS unsigned* parke = (const LAS unsigned*)stge + le;
            unsigned o2p[4][8];
#pragma unroll
            for (int d0 = 0; d0 < 4; ++d0)
#pragma unroll
                for (int k = 0; k < 8; ++k) o2p[d0][k] = parke[(d0 * 8 + k) * 64];
            asm volatile("s_waitcnt lgkmcnt(0)" ::: "memory");
            const float scl = 1.0f / sa::swap_sum(l);
            if (hie == 0) wsfe[32 + r32e] = scl;
#pragma unroll
            for (int rd = 0; rd < 2; ++rd) {
#pragma unroll
                for (int gg = 0; gg < 2; ++gg) { const int g = 2 * rd + gg; const f32x4 s4 = *(const LAS f32x4*)(wsfe + 32 + 8 * g + 4 * hie);
#pragma unroll
                    for (int d0 = 0; d0 < 4; ++d0)
#pragma unroll
                        for (int j = 0; j < 4; ++j) { const unsigned w2 = o2p[d0][2 * g + (j >> 1)]; const float o2 = (j & 1) ? sa::bf_hi(w2) : sa::bf_lo(w2);
                            stge[(8 * gg + 4 * hie + j) * 128 + d0 * 32 + r32e] = o[d0][4 * g + j] * s4[j] - lam * o2; } }
#pragma unroll
                for (int ii = 0; ii < 4; ++ii) { const int row = ii * 4 + (le >> 4), c8 = le & 15;
                    const f32x4 a = *(const LAS f32x4*)(stge + row * 128 + c8 * 8), bb = *(const LAS f32x4*)(stge + row * 128 + c8 * 8 + 4);
                    float q = (a[0] * a[0] + a[1] * a[1]) + (a[2] * a[2] + a[3] * a[3]) + (bb[0] * bb[0] + bb[1] * bb[1]) + (bb[2] * bb[2] + bb[3] * bb[3]);
                    q += __shfl_xor(q, 1); q += __shfl_xor(q, 2); q += __shfl_xor(q, 4); q += __shfl_xor(q, 8);
                    const float rn = (1.0f - LAMBDA_INIT) / sqrtf(q * (1.0f / 128.0f) + EPS);
                    const f32x4 g0 = *(const f32x4*)(subg + c8 * 8), g1 = *(const f32x4*)(subg + c8 * 8 + 4);
                    const size_t grow = qrow0 + 16 * rd + row;
                    const u32x4 gt = *(const u32x4*)(G1 + grow * 1024 + h * 128 + c8 * 8);
                    u32x4 w; w.x = sa::cvtpk(a[0] * rn * g0[0] * sa::bf_lo(gt.x), a[1] * rn * g0[1] * sa::bf_hi(gt.x)); w.y = sa::cvtpk(a[2] * rn * g0[2] * sa::bf_lo(gt.y), a[3] * rn * g0[3] * sa::bf_hi(gt.y));
                    w.z = sa::cvtpk(bb[0] * rn * g1[0] * sa::bf_lo(gt.z), bb[1] * rn * g1[1] * sa::bf_hi(gt.z)); w.w = sa::cvtpk(bb[2] * rn * g1[2] * sa::bf_lo(gt.w), bb[3] * rn * g1[3] * sa::bf_hi(gt.w));
                    *(u32x4*)(MIX + grow * DM + h * 128 + c8 * 8) = w; }
            }
        }
        asm volatile("s_waitcnt vmcnt(0) lgkmcnt(0)" ::: "memory");
        __syncthreads();
    }
    SEAM(5);

    if (IN(6)) {
        pg8::Gemm g{MIX, WO1T, M_ROWS, DM, DM}; pg8::StaticOrder S; S.init(M_ROWS, DM, G, bx);
        pg8::EpiRes E{nullptr, XN, out, nullptr, nullptr};
        pg8::gemm_phase<pg8::EpiRes, pg8::StaticOrder, true, true>(lds, g, S, E);
    }
#undef IN
#undef SEAM
}

extern "C" void kernel_launch(void* const* d_in, const int* in_sizes, int n_in, void* d_out, int out_size, void* d_ws, size_t ws_size, hipStream_t stream) {
    static int grid = 0;
    if (grid == 0) {
        if (n_in != 20 || in_sizes[0] != M_ROWS * DM || out_size != M_ROWS * DM || ws_size < WS_END) {
            fprintf(stderr, "kernel_launch: unexpected problem (n_in %d, in0 %d, out %d, ws %zu; need ws >= %zu); nothing launched\n", n_in, n_in > 0 ? in_sizes[0] : -1, out_size, ws_size, (size_t)WS_END);
            grid = -1; return; }
        int dev = 0, cus = 0, per_cu = 0;
        if (hipGetDevice(&dev) != hipSuccess || hipDeviceGetAttribute(&cus, hipDeviceAttributeMultiprocessorCount, dev) != hipSuccess) { fprintf(stderr, "kernel_launch: device query failed\n"); grid = -1; return; }
        if (hipFuncSetAttribute((const void*)fwd_kernel, hipFuncAttributeMaxDynamicSharedMemorySize, LDS_BYTES) != hipSuccess) { fprintf(stderr, "kernel_launch: hipFuncSetAttribute failed\n"); grid = -1; return; }
        if (hipOccupancyMaxActiveBlocksPerMultiprocessor(&per_cu, (const void*)fwd_kernel, NWAVES * 64, LDS_BYTES) != hipSuccess || per_cu < 1) {
            fprintf(stderr, "kernel_launch: the occupancy query admits %d workgroups of this kernel per CU; nothing launched\n", per_cu); (void)hipGetLastError(); grid = -1; return; }
        grid = cus * (per_cu < 1 ? per_cu : 1);
    }
    if (grid < 0) return;
    if (hipMemsetAsync(d_ws, 0, XCD_BAR_WORDS * 4, stream) != hipSuccess) { fprintf(stderr, "kernel_launch: hipMemsetAsync of the barrier words failed\n"); return; }
    Args a{};
    for (int i = 0; i < 20; ++i) a.in[i] = (const float*)d_in[i];
    a.out = (float*)d_out; a.ws = (unsigned char*)d_ws;
#if MK_N_LAUNCHES == 1
    a.ph_lo = 0; a.ph_hi = N_PHASES;
    void* kargs[] = {&a};
    hipError_t e = hipLaunchCooperativeKernel((const void*)fwd_kernel, dim3(grid), dim3(NWAVES * 64), kargs, LDS_BYTES, stream);
    if (e != hipSuccess) fprintf(stderr, "kernel_launch: cooperative launch failed: %s (grid %d)\n", hipGetErrorString(e), grid);
#else
    for (int p = 0; p < N_PHASES; ++p) {
        a.ph_lo = p; a.ph_hi = p + 1;
        for (int rep = 1; rep < (p == PROBE_PHASE ? PROBE_REPS : 1); ++rep) hipLaunchKernelGGL(fwd_kernel, dim3(grid), dim3(NWAVES * 64), LDS_BYTES, stream, a);
        hipLaunchKernelGGL(fwd_kernel, dim3(grid), dim3(NWAVES * 64), LDS_BYTES, stream, a);
        const hipError_t le = hipPeekAtLastError();
        if (le != hipSuccess) { fprintf(stderr, "kernel_launch: launch %d failed: %s\n", p, hipGetErrorName(le)); break; }
    }
#endif
}
```
